# Optimizing an MI355X kernel written in HIP

```python
import math
import jax, jax.numpy as jnp
from jax import lax
import numpy as np

D_MODEL = 2048
BATCH = 2
SEQ = 4096
DEPTH = 4
DEC_BATCH = 32
DEC_SEQ = 1
PAST_LEN = 16384
PAGE_SIZE = 128

N_MIXERS = 4
N_ATTN = (DEPTH + 3) // N_MIXERS
N_CONV = (DEPTH + 2) // N_MIXERS
N_SSM = (DEPTH + 1) // N_MIXERS
N_MLP = DEPTH // N_MIXERS

HEAD_DIM = 64
N_HEADS = D_MODEL // HEAD_DIM
N_KV_HEADS = N_HEADS // 8
Q_PER_KV = N_HEADS // N_KV_HEADS
WINDOW = 128
ATTN_BLOCK = 128
ATTN_SCALE = HEAD_DIM ** -0.5
NEG_BIG = -1e30
CONV_WIDTH = 3
SSM_GROUP = 16
SSM_GROUPS = D_MODEL // SSM_GROUP
SSM_STATE = 64
DT_MIN = 1e-3
DT_MAX = 1e-1
GM_CHUNK = 128
GM_HALF = D_MODEL
GM_GROUP = 128
GM_GROUPS = GM_HALF // GM_GROUP
D_FF = 5632
EPS = 1e-6

kernel_name = 'hybrid_swa_conv_s5_gmlp_decode_step'


def rms_norm(x, g):
    x32 = x.astype(jnp.float32)
    y = x32 * lax.rsqrt(jnp.mean(x32 * x32, axis=-1, keepdims=True) + EPS)
    return (y * g.astype(jnp.float32)).astype(x.dtype)


def swiglu(x, w_gu, w_down):
    gate, up = jnp.split(x @ w_gu, 2, axis=-1)
    return (jax.nn.silu(gate) * up) @ w_down


def half_ffn(x, g_pre, g_post, w_gu, w_down):
    return x + 0.5 * rms_norm(swiglu(rms_norm(x, g_pre), w_gu, w_down), g_post)


def qkv_split(qkv, b, t):
    nq, nk = N_HEADS * HEAD_DIM, N_KV_HEADS * HEAD_DIM
    q = qkv[..., :nq].reshape(b, t, N_KV_HEADS, Q_PER_KV, HEAD_DIM)
    k = qkv[..., nq:nq + nk].reshape(b, t, N_KV_HEADS, HEAD_DIM)
    v = qkv[..., nq + nk:].reshape(b, t, N_KV_HEADS, HEAD_DIM)
    return q, k, v


def sink_softmax(scores, mask, sinks):
    sink = sinks.astype(jnp.float32).reshape(N_KV_HEADS, Q_PER_KV)[:, :, None]
    s = jnp.where(mask, scores, NEG_BIG)
    m = jnp.maximum(jnp.max(s, axis=-1), sink)
    p = jnp.exp(s - m[..., None])
    denom = jnp.sum(p, axis=-1) + jnp.exp(sink - m)
    return p / denom[..., None]


def band_rows(xb):
    prev = jnp.concatenate([jnp.zeros_like(xb[:, :1]), xb[:, :-1]], axis=1)
    return jnp.concatenate([prev, xb], axis=2)


def swa_prompt(h, w_qkv, w_o, sinks):
    b, s, _ = h.shape
    q, k, v = qkv_split(h @ w_qkv, b, s)
    nb = s // ATTN_BLOCK
    qb = q.reshape(b, nb, ATTN_BLOCK, N_KV_HEADS, Q_PER_KV, HEAD_DIM)
    kb = band_rows(k.reshape(b, nb, ATTN_BLOCK, N_KV_HEADS, HEAD_DIM))
    vb = band_rows(v.reshape(b, nb, ATTN_BLOCK, N_KV_HEADS, HEAD_DIM))
    scores = jnp.einsum('bnqkgd,bnskd->bnkgqs', qb, kb).astype(jnp.float32) * ATTN_SCALE
    blk = jnp.arange(nb)[:, None] * ATTN_BLOCK
    qpos = blk + jnp.arange(ATTN_BLOCK)[None, :]
    kpos = blk - ATTN_BLOCK + jnp.arange(2 * ATTN_BLOCK)[None, :]
    diff = qpos[:, :, None] - kpos[:, None, :]
    mask = (diff >= 0) & (diff < WINDOW) & (kpos[:, None, :] >= 0)
    probs = sink_softmax(scores, mask[None, :, None, None], sinks)
    o = jnp.einsum('bnkgqs,bnskd->bnqkgd', probs.astype(h.dtype), vb)
    o = o.reshape(b, s, N_HEADS * HEAD_DIM)
    keep = min(WINDOW, s)
    return o @ w_o, k[:, s - keep:], v[:, s - keep:]


def swa_sample(h, buf_k, buf_v, w_qkv, w_o, sinks):
    b, t, _ = h.shape
    q, k, v = qkv_split(h @ w_qkv, b, t)
    w_buf = buf_k.shape[1]
    keys = jnp.concatenate([buf_k.astype(k.dtype), k], axis=1)
    vals = jnp.concatenate([buf_v.astype(v.dtype), v], axis=1)
    qpos = jnp.arange(t)
    kpos = jnp.arange(w_buf + t) - w_buf
    diff = qpos[:, None] - kpos[None, :]
    mask = (diff >= 0) & (diff < WINDOW)
    scores = jnp.einsum('bqkgd,bskd->bkgqs', q, keys).astype(jnp.float32) * ATTN_SCALE
    probs = sink_softmax(scores, mask, sinks)
    o = jnp.einsum('bkgqs,bskd->bqkgd', probs.astype(h.dtype), vals).reshape(b, t, N_HEADS * HEAD_DIM)
    return o @ w_o, keys[:, -w_buf:], vals[:, -w_buf:]


def short_conv(h, prev, w_in, w_conv, w_out):
    bg, cg, hv = jnp.split(h @ w_in, 3, axis=-1)
    y = cg * hv
    t = y.shape[1]
    ypad = jnp.concatenate([prev.astype(y.dtype), y], axis=1)
    z = w_conv[0] * ypad[:, 0:t]
    for i in range(1, CONV_WIDTH):
        z = z + w_conv[i] * ypad[:, i:i + t]
    return (bg * z) @ w_out, ypad[:, -(CONV_WIDTH - 1):]


def s5_mixer(h, h0_re, h0_im, a_re, a_im, log_dt, b_re, b_im, c_re, c_im, d_skip, w_gate, b_gate):
    f32 = jnp.float32
    b, t, _ = h.shape
    u = h.astype(f32).reshape(b, t, SSM_GROUPS, SSM_GROUP)
    dt = jnp.exp(log_dt.astype(f32))[:, None]
    lr, li = a_re.astype(f32), a_im.astype(f32)
    mag = jnp.exp(lr * dt)
    ab_re, ab_im = mag * jnp.cos(li * dt), mag * jnp.sin(li * dt)
    den = lr * lr + li * li
    k_re = ((ab_re - 1.0) * lr + ab_im * li) / den
    k_im = (ab_im * lr - (ab_re - 1.0) * li) / den
    br, bi = b_re.astype(f32), b_im.astype(f32)
    bb_re = k_re[..., None] * br - k_im[..., None] * bi
    bb_im = k_re[..., None] * bi + k_im[..., None] * br
    bu_re = jnp.einsum('btgc,gpc->btgp', u, bb_re)
    bu_im = jnp.einsum('btgc,gpc->btgp', u, bb_im)
    a_re_s = jnp.broadcast_to(ab_re, bu_re.shape)
    a_im_s = jnp.broadcast_to(ab_im, bu_im.shape)

    def combine(e1, e2):
        a1r, a1i, b1r, b1i = e1
        a2r, a2i, b2r, b2i = e2
        return (a2r * a1r - a2i * a1i, a2r * a1i + a2i * a1r,
                a2r * b1r - a2i * b1i + b2r, a2r * b1i + a2i * b1r + b2i)

    pr, pi, sr, si = lax.associative_scan(combine, (a_re_s, a_im_s, bu_re, bu_im), axis=1)
    h0r = h0_re.astype(f32)[:, None]
    h0i = h0_im.astype(f32)[:, None]
    hr = pr * h0r - pi * h0i + sr
    hi = pr * h0i + pi * h0r + si
    y = (jnp.einsum('btgp,gcp->btgc', hr, c_re.astype(f32))
         - jnp.einsum('btgp,gcp->btgc', hi, c_im.astype(f32))
         + d_skip.astype(f32) * u).reshape(b, t, D_MODEL)
    z = jax.nn.gelu(y)
    out = z * jax.nn.sigmoid(z @ w_gate.astype(f32) + b_gate.astype(f32))
    return out.astype(h.dtype), hr[:, -1], hi[:, -1]


def chunk_gmlp(h, chunk, w_uv, ln_g, ln_b, w_s, b_s, w_out):
    b, t, _ = h.shape
    u, v = jnp.split(jax.nn.gelu(h @ w_uv), 2, axis=-1)
    v32 = v.astype(jnp.float32)
    mu = jnp.mean(v32, axis=-1, keepdims=True)
    var = jnp.mean(jnp.square(v32 - mu), axis=-1, keepdims=True)
    vn = ((v32 - mu) * lax.rsqrt(var + EPS) * ln_g.astype(jnp.float32)
          + ln_b.astype(jnp.float32)).astype(h.dtype)
    nc = t // chunk
    vc = vn.reshape(b, nc, chunk, GM_GROUPS, GM_GROUP)
    ws = jnp.tril(w_s[:, :chunk, :chunk])
    s = jnp.einsum('gts,bnsgc->bntgc', ws, vc) + b_s[:, :chunk].T[:, :, None]
    s = s.reshape(b, t, GM_HALF)
    return (u * s) @ w_out, vn


def setup_inputs(seed: int = 0) -> dict:
    key = jax.random.key(seed)
    keys = iter(jax.random.split(key, 40))
    f32 = jnp.float32

    def nrm(shape, scale):
        return jax.random.normal(next(keys), shape, f32) * scale

    w_buf = min(WINDOW, PAST_LEN)
    qkv_out = (N_HEADS + 2 * N_KV_HEADS) * HEAD_DIM
    log_dt = jax.random.uniform(next(keys), (N_SSM, SSM_GROUPS), f32,
                                math.log(DT_MIN), math.log(DT_MAX))
    return {
        'x_prompt': nrm((BATCH, SEQ, D_MODEL), 1.0),
        'x_sample': nrm((DEC_BATCH, DEC_SEQ, D_MODEL), 1.0),
        'cache_k': nrm((N_ATTN, DEC_BATCH, w_buf, N_KV_HEADS, HEAD_DIM), 1.0),
        'cache_v': nrm((N_ATTN, DEC_BATCH, w_buf, N_KV_HEADS, HEAD_DIM), 1.0),
        'state_conv': nrm((N_CONV, DEC_BATCH, CONV_WIDTH - 1, D_MODEL), 0.5),
        'state_ssm_re': nrm((N_SSM, DEC_BATCH, SSM_GROUPS, SSM_STATE), 0.1),
        'state_ssm_im': nrm((N_SSM, DEC_BATCH, SSM_GROUPS, SSM_STATE), 0.1),
        'norm_g': 1.0 + nrm((DEPTH, 6, D_MODEL), 0.05),
        'ffn_w_gu': nrm((DEPTH, 2, D_MODEL, 2 * D_FF), D_MODEL ** -0.5),
        'ffn_w_down': nrm((DEPTH, 2, D_FF, D_MODEL), D_FF ** -0.5),
        'attn_w_qkv': nrm((N_ATTN, D_MODEL, qkv_out), D_MODEL ** -0.5),
        'attn_w_o': nrm((N_ATTN, N_HEADS * HEAD_DIM, D_MODEL), (N_HEADS * HEAD_DIM) ** -0.5),
        'attn_sinks': nrm((N_ATTN, N_HEADS), 1.0),
        'conv_w_in': nrm((N_CONV, D_MODEL, 3 * D_MODEL), D_MODEL ** -0.5),
        'conv_w': nrm((N_CONV, CONV_WIDTH, D_MODEL), CONV_WIDTH ** -0.5),
        'conv_w_out': nrm((N_CONV, D_MODEL, D_MODEL), D_MODEL ** -0.5),
        'ssm_a_re': -0.5 + nrm((N_SSM, SSM_GROUPS, SSM_STATE), 0.01),
        'ssm_a_im': math.pi * jnp.arange(SSM_STATE, dtype=f32) + nrm((N_SSM, SSM_GROUPS, SSM_STATE), 0.01),
        'ssm_log_dt': log_dt,
        'ssm_b_re': nrm((N_SSM, SSM_GROUPS, SSM_STATE, SSM_GROUP), (2 * SSM_GROUP) ** -0.5),
        'ssm_b_im': nrm((N_SSM, SSM_GROUPS, SSM_STATE, SSM_GROUP), (2 * SSM_GROUP) ** -0.5),
        'ssm_c_re': nrm((N_SSM, SSM_GROUPS, SSM_GROUP, SSM_STATE), SSM_STATE ** -0.5),
        'ssm_c_im': nrm((N_SSM, SSM_GROUPS, SSM_GROUP, SSM_STATE), SSM_STATE ** -0.5),
        'ssm_d': nrm((N_SSM, SSM_GROUPS, SSM_GROUP), 1.0),
        'ssm_w_gate': nrm((N_SSM, D_MODEL, D_MODEL), D_MODEL ** -0.5),
        'ssm_b_gate': nrm((N_SSM, D_MODEL), 0.01),
        'gm_w_uv': nrm((N_MLP, D_MODEL, 2 * GM_HALF), D_MODEL ** -0.5),
        'gm_ln_g': 1.0 + nrm((N_MLP, GM_HALF), 0.05),
        'gm_ln_b': nrm((N_MLP, GM_HALF), 0.01),
        'gm_w_s': nrm((N_MLP, GM_GROUPS, GM_CHUNK, GM_CHUNK), GM_CHUNK ** -0.5),
        'gm_b_s': 1.0 + nrm((N_MLP, GM_GROUPS, GM_CHUNK), 0.01),
        'gm_w_out': nrm((N_MLP, GM_HALF, D_MODEL), GM_HALF ** -0.5),
    }


def reference(x_prompt, x_sample, cache_k, cache_v, state_conv, state_ssm_re, state_ssm_im,
              norm_g, ffn_w_gu, ffn_w_down, attn_w_qkv, attn_w_o, attn_sinks,
              conv_w_in, conv_w, conv_w_out,
              ssm_a_re, ssm_a_im, ssm_log_dt, ssm_b_re, ssm_b_im, ssm_c_re, ssm_c_im, ssm_d,
              ssm_w_gate, ssm_b_gate,
              gm_w_uv, gm_ln_g, gm_ln_b, gm_w_s, gm_b_s, gm_w_out):
    xp, xs = x_prompt, x_sample
    kp_l, vp_l, ks_l, vs_l = [], [], [], []
    cp_l, cs_l = [], []
    srp_l, sip_l, srs_l, sis_l = [], [], [], []
    gv_l = []
    for i in range(DEPTH):
        kind, j = i % N_MIXERS, i // N_MIXERS
        g = norm_g[i]
        xp = half_ffn(xp, g[0], g[1], ffn_w_gu[i, 0], ffn_w_down[i, 0])
        xs = half_ffn(xs, g[0], g[1], ffn_w_gu[i, 0], ffn_w_down[i, 0])
        hp, hs = rms_norm(xp, g[2]), rms_norm(xs, g[2])
        if kind == 0:
            mp, kp, vp = swa_prompt(hp, attn_w_qkv[j], attn_w_o[j], attn_sinks[j])
            ms, ks, vs = swa_sample(hs, cache_k[j], cache_v[j], attn_w_qkv[j], attn_w_o[j], attn_sinks[j])
            kp_l.append(kp); vp_l.append(vp); ks_l.append(ks); vs_l.append(vs)
        elif kind == 1:
            zeros = jnp.zeros((hp.shape[0], CONV_WIDTH - 1, D_MODEL), hp.dtype)
            mp, cp = short_conv(hp, zeros, conv_w_in[j], conv_w[j], conv_w_out[j])
            ms, cs = short_conv(hs, state_conv[j], conv_w_in[j], conv_w[j], conv_w_out[j])
            cp_l.append(cp); cs_l.append(cs)
        elif kind == 2:
            z0 = jnp.zeros((hp.shape[0], SSM_GROUPS, SSM_STATE), jnp.float32)
            prm = (ssm_a_re[j], ssm_a_im[j], ssm_log_dt[j], ssm_b_re[j], ssm_b_im[j],
                   ssm_c_re[j], ssm_c_im[j], ssm_d[j], ssm_w_gate[j], ssm_b_gate[j])
            mp, srp, sip = s5_mixer(hp, z0, z0, *prm)
            ms, srs, sis = s5_mixer(hs, state_ssm_re[j], state_ssm_im[j], *prm)
            srp_l.append(srp); sip_l.append(sip); srs_l.append(srs); sis_l.append(sis)
        else:
            prm = (gm_w_uv[j], gm_ln_g[j], gm_ln_b[j], gm_w_s[j], gm_b_s[j], gm_w_out[j])
            mp, _ = chunk_gmlp(hp, min(GM_CHUNK, hp.shape[1]), *prm)
            ms, gv = chunk_gmlp(hs, hs.shape[1], *prm)
            gv_l.append(gv)
        xp = xp + rms_norm(mp, g[3])
        xs = xs + rms_norm(ms, g[3])
        xp = half_ffn(xp, g[4], g[5], ffn_w_gu[i, 1], ffn_w_down[i, 1])
        xs = half_ffn(xs, g[4], g[5], ffn_w_gu[i, 1], ffn_w_down[i, 1])
    return (xp, xs,
            jnp.stack(kp_l), jnp.stack(vp_l), jnp.stack(ks_l), jnp.stack(vs_l),
            jnp.stack(cp_l), jnp.stack(cs_l),
            jnp.stack(srp_l), jnp.stack(sip_l), jnp.stack(srs_l), jnp.stack(sis_l),
            jnp.stack(gv_l))
```

```cpp
#include <hip/hip_runtime.h>
#include <cstdio>
#include <cstdint>
namespace pg8 {
#define PG8_LAS __attribute__((address_space(3)))
typedef unsigned short bf16_t;
typedef short bf16x8 __attribute__((ext_vector_type(8)));
typedef float f32x4 __attribute__((ext_vector_type(4)));
typedef unsigned u32x4 __attribute__((ext_vector_type(4)));
typedef int i32x4 __attribute__((ext_vector_type(4)));
constexpr int BM = 256, BK = 64, HALF = 128, HTB = HALF * BK * 2  , STAGE_BYTES = 8 * HTB, NXCD = 8, WGM = 8;

__host__ __device__ __forceinline__ int lds_byte(int r, int c) { const int st = (r >> 4) * 2 + (c >> 5), rr = r & 15, cc = c & 31, ob = rr * 64 + cc * 2; return st * 1024 + (ob ^ (((ob >> 9) & 1) << 5)); }
__host__ __device__ __forceinline__ void stage_rc(int b, int& R, int& C) { const int st = b / 1024, sb = b % 1024, swz = sb ^ (((sb >> 9) & 1) << 5); R = (st >> 1) * 16 + swz / 64; C = (st & 1) * 32 + (swz % 64) / 2; }
__host__ __device__ __forceinline__ int perm32(int rho) { const int n = rho >> 4, i = rho & 15; return 8 * (i >> 2) + 4 * n + (i & 3); }

struct Unit { int pm, pn; };
struct Gemm { const bf16_t* A; const bf16_t* Bt; int M, N, K; };

struct StaticOrder {
    int nM, nN, nwg, G, c;
    __host__ __device__ void init(int M, int N, int G_, int c_) { nM = M / BM; nN = N / BM; nwg = nM * nN; G = G_; c = c_; }
    __host__ __device__ __forceinline__ bool next(int i, Unit& u) const {
        const long L = (long)i * G + c; if (L >= nwg) return false;
        int wgid = (int)L; { const int q = nwg / NXCD, r = nwg % NXCD, xcd = wgid % NXCD, off = wgid / NXCD; wgid = (xcd < r ? xcd * (q + 1) : r * (q + 1) + (xcd - r) * q) + off; }
        const int nig = WGM * nN, gid = wgid / nig, fm = gid * WGM, gsz = (nM - fm) < WGM ? (nM - fm) : WGM;
        u.pm = fm + ((wgid % nig) % gsz); u.pn = (wgid % nig) / gsz; return true;
    }
    __device__ __forceinline__ void a_ready(const Unit&) const {}
    __device__ __forceinline__ void done(const Unit&) const {}
};


__device__ __forceinline__ unsigned cvt_pk_bf16(float lo, float hi) { unsigned r; asm volatile("v_cvt_pk_bf16_f32 %0, %1, %2" : "=v"(r) : "v"(lo), "v"(hi)); return r; }
__device__ __forceinline__ float fast_sigmoid(float v) { return __builtin_amdgcn_rcpf(1.0f + __builtin_amdgcn_exp2f(-1.4426950408889634f * v)); }
__device__ __forceinline__ float silu_f(float v) { return v * fast_sigmoid(v); }
typedef float f32x2_t __attribute__((ext_vector_type(2)));
__device__ __forceinline__ f32x2_t gelu_tanh_pk(f32x2_t v) {
    const f32x2_t p = (v * v) * -0.10294324064f + -2.30220819814f;
    const f32x2_t a = v * p;
    const f32x2_t d = (f32x2_t){__builtin_amdgcn_exp2f(a.x), __builtin_amdgcn_exp2f(a.y)} + 1.0f;
    return v * (f32x2_t){__builtin_amdgcn_rcpf(d.x), __builtin_amdgcn_rcpf(d.y)};
}
__device__ __forceinline__ float gelu_tanh_f(float v) { const float t = v * (1.0f + 0.044715f * v * v) * 1.5957691216057308f; return v * fast_sigmoid(t); }
__device__ __forceinline__ float bf2f(unsigned short b) { return __builtin_bit_cast(float, (unsigned)b << 16); }

struct EpiF32 {
    static constexpr bool PERM = false, AFTER_DRAIN = false;
    float* C; int ldc;
    __device__ __forceinline__ void operator()(const f32x4 (&acc)[2][2][4][2], const Unit& u, int wr, int wc, int fr, int fq) const {
        const int row0 = u.pm * BM + wr * 64 + fr, col0 = u.pn * BM + wc * 32 + 4 * fq;
#pragma unroll
        for (int ai = 0; ai < 2; ++ai)
#pragma unroll
            for (int m = 0; m < 4; ++m) { float* rowp = C + (size_t)(row0 + ai * HALF + m * 16) * ldc + col0;
#pragma unroll
                for (int bj = 0; bj < 2; ++bj)
#pragma unroll
                    for (int n = 0; n < 2; ++n) *(f32x4*)(rowp + bj * HALF + n * 16) = acc[ai][bj][m][n]; }
    }
};
struct EpiGate {
    static constexpr bool PERM = true, AFTER_DRAIN = false;
    bf16_t* C; const bf16_t* Z; const float* bias; int ldc;
    __device__ __forceinline__ void operator()(const f32x4 (&acc)[2][2][4][2], const Unit& u, int wr, int wc, int fr, int fq) const {
        const int row0 = u.pm * BM + wr * 64 + fr, col0 = u.pn * BM + wc * 32 + 8 * fq;
        f32x4 bv[2][2];
#pragma unroll
        for (int bj = 0; bj < 2; ++bj)
#pragma unroll
            for (int n = 0; n < 2; ++n) bv[bj][n] = *(const f32x4*)(bias + col0 + bj * HALF + 4 * n);
#pragma unroll
        for (int ai = 0; ai < 2; ++ai) {
            u32x4 zq[4][2];
#pragma unroll
            for (int m = 0; m < 4; ++m)
#pragma unroll
                for (int bj = 0; bj < 2; ++bj) zq[m][bj] = *(const u32x4*)(Z + (size_t)(row0 + ai * HALF + m * 16) * ldc + col0 + bj * HALF);
#pragma unroll
            for (int m = 0; m < 4; ++m) { const size_t off = (size_t)(row0 + ai * HALF + m * 16) * ldc + col0;
#pragma unroll
                for (int bj = 0; bj < 2; ++bj) { const u32x4 zz = zq[m][bj]; const unsigned zw[4] = {zz.x, zz.y, zz.z, zz.w}; float o[8];
#pragma unroll
                    for (int n = 0; n < 2; ++n)
#pragma unroll
                        for (int e = 0; e < 4; ++e) { const unsigned w = zw[2 * n + (e >> 1)]; const float zv = bf2f((unsigned short)((e & 1) ? (w >> 16) : (w & 0xffffu))); o[4 * n + e] = zv * fast_sigmoid(acc[ai][bj][m][n][e] + bv[bj][n][e]); }
                    u32x4 w; w.x = cvt_pk_bf16(o[0], o[1]); w.y = cvt_pk_bf16(o[2], o[3]); w.z = cvt_pk_bf16(o[4], o[5]); w.w = cvt_pk_bf16(o[6], o[7]);
                    *(u32x4*)(C + off + bj * HALF) = w; } } }
    }
};
template <int MODE> struct EpiPair {
    static constexpr bool PERM = true, AFTER_DRAIN = false;
    bf16_t* O; int ldc; int npair; bf16_t* O2; int ldc2;
    __device__ __forceinline__ void operator()(const f32x4 (&acc)[2][2][4][2], const Unit& u, int wr, int wc, int fr, int fq) const {
        const int row0 = u.pm * BM + wr * 64 + fr;
        if (u.pn < npair) {
            const int col0 = u.pn * HALF + wc * 32 + 8 * fq;
#ifdef REP_EPI_PAIR
#pragma unroll 1
            for (int rep_ = 0; rep_ < REP_EPI_PAIR; ++rep_)
#endif
#pragma unroll
            for (int ai = 0; ai < 2; ++ai)
#pragma unroll
                for (int m = 0; m < 4; ++m) { bf16_t* rowp = O + (size_t)(row0 + ai * HALF + m * 16) * ldc + col0;
                    float r[8];
#pragma unroll
                    for (int n = 0; n < 2; ++n)
#pragma unroll
                        for (int e = 0; e < 4; ++e) { const float a = acc[ai][0][m][n][e], b = acc[ai][1][m][n][e]; r[4 * n + e] = (MODE == 0 ? silu_f(a) : a) * b; }
                    u32x4 w; w.x = cvt_pk_bf16(r[0], r[1]); w.y = cvt_pk_bf16(r[2], r[3]); w.z = cvt_pk_bf16(r[4], r[5]); w.w = cvt_pk_bf16(r[6], r[7]);
                    *(u32x4*)rowp = w; }
        } else {
            const int col0 = (u.pn - npair) * BM + wc * 32 + 8 * fq;
#pragma unroll
            for (int ai = 0; ai < 2; ++ai)
#pragma unroll
                for (int m = 0; m < 4; ++m) { bf16_t* rowp = O2 + (size_t)(row0 + ai * HALF + m * 16) * ldc2 + col0;
#pragma unroll
                    for (int bj = 0; bj < 2; ++bj) { const f32x4 v0 = acc[ai][bj][m][0], v1 = acc[ai][bj][m][1];
                        u32x4 w; w.x = cvt_pk_bf16(v0[0], v0[1]); w.y = cvt_pk_bf16(v0[2], v0[3]); w.z = cvt_pk_bf16(v1[0], v1[1]); w.w = cvt_pk_bf16(v1[2], v1[3]);
                        *(u32x4*)(rowp + bj * HALF) = w; } }
        }
    }
};
template <int ACT> struct EpiSplit {
    static constexpr bool PERM = true, AFTER_DRAIN = false;
    bf16_t* O0; int ld0, n0; bf16_t* O1; int ld1, n1; bf16_t* O2; int ld2;
    __device__ __forceinline__ void operator()(const f32x4 (&acc)[2][2][4][2], const Unit& u, int wr, int wc, int fr, int fq) const {
        const int row0 = u.pm * BM + wr * 64 + fr;
        bf16_t* base; int ld, t = u.pn;
        if (t < n0) { base = O0; ld = ld0; } else if (t - n0 < n1) { base = O1; ld = ld1; t -= n0; } else { base = O2; ld = ld2; t -= n0 + n1; }
        const int col0 = t * BM + wc * 32 + 8 * fq;
#pragma unroll
        for (int ai = 0; ai < 2; ++ai)
#pragma unroll
            for (int m = 0; m < 4; ++m) { bf16_t* rowp = base + (size_t)(row0 + ai * HALF + m * 16) * ld + col0;
#pragma unroll
                for (int bj = 0; bj < 2; ++bj) { f32x4 v0 = acc[ai][bj][m][0], v1 = acc[ai][bj][m][1];
                    if (ACT == 1) { const f32x2_t a0 = gelu_tanh_pk((f32x2_t){v0.x, v0.y}), a1 = gelu_tanh_pk((f32x2_t){v0.z, v0.w}), b0 = gelu_tanh_pk((f32x2_t){v1.x, v1.y}), b1 = gelu_tanh_pk((f32x2_t){v1.z, v1.w});
                        v0 = (f32x4){a0.x, a0.y, a1.x, a1.y}; v1 = (f32x4){b0.x, b0.y, b1.x, b1.y}; }
                    u32x4 w; w.x = cvt_pk_bf16(v0[0], v0[1]); w.y = cvt_pk_bf16(v0[2], v0[3]); w.z = cvt_pk_bf16(v1[0], v1[1]); w.w = cvt_pk_bf16(v1[2], v1[3]);
                    *(u32x4*)(rowp + bj * HALF) = w; } }
    }
};


struct EpiPairI8 {
    static constexpr bool PERM = true, AFTER_DRAIN = false;
    bf16_t* O; int ldc; const PG8_LAS float* sc;
    __device__ __forceinline__ void operator()(const i32x4 (&acc)[2][2][4][2], const Unit& u, int wr, int wc, int fr, int fq, int ui) const {
        typedef float f32x2 __attribute__((ext_vector_type(2)));
        const PG8_LAS float* s = sc + ui * 512;
        const int rl = wr * 64 + fr, col0 = u.pn * HALF + wc * 32 + 8 * fq, lc = 256 + wc * 32 + 8 * fq;
        f32x2 ca[2][2], cab[2][2];
#pragma unroll
        for (int n = 0; n < 2; ++n) { const f32x4 a = *(const PG8_LAS f32x4*)(s + lc + 4 * n), b = *(const PG8_LAS f32x4*)(s + lc + HALF + 4 * n);
            ca[n][0] = (f32x2){a.x, a.y} * -1.4426950408889634f; ca[n][1] = (f32x2){a.z, a.w} * -1.4426950408889634f;
            cab[n][0] = (f32x2){a.x, a.y} * (f32x2){b.x, b.y}; cab[n][1] = (f32x2){a.z, a.w} * (f32x2){b.z, b.w}; }
#ifdef REP_EPI_PAIR
#pragma unroll 1
        for (int rep_ = 0; rep_ < REP_EPI_PAIR; ++rep_)
#endif
#pragma unroll
        for (int ai = 0; ai < 2; ++ai)
#pragma unroll
            for (int m = 0; m < 4; ++m) { const int lr = rl + ai * HALF + m * 16; bf16_t* rowp = O + (size_t)(u.pm * BM + lr) * ldc + col0; const float rsc = s[lr], rsq = rsc * rsc;
                u32x4 w;
#pragma unroll
                for (int n = 0; n < 2; ++n)
#pragma unroll
                    for (int e2 = 0; e2 < 2; ++e2) {
                        const f32x2 ia = (f32x2){(float)acc[ai][0][m][n][2 * e2], (float)acc[ai][0][m][n][2 * e2 + 1]}, ib = (f32x2){(float)acc[ai][1][m][n][2 * e2], (float)acc[ai][1][m][n][2 * e2 + 1]};
                        const f32x2 t = ia * (ca[n][e2] * rsc);
                        const f32x2 d = (f32x2){__builtin_amdgcn_exp2f(t.x), __builtin_amdgcn_exp2f(t.y)} + 1.0f;
                        const f32x2 r = (f32x2){__builtin_amdgcn_rcpf(d.x), __builtin_amdgcn_rcpf(d.y)};
                        const f32x2 o = ((ia * ib) * (cab[n][e2] * rsq)) * r;
                        w[2 * n + e2] = cvt_pk_bf16(o.x, o.y); }
                *(u32x4*)rowp = w; asm volatile("" ::: "memory"); }
    }
};
template <class E> struct EpiWantsUi { static constexpr bool value = false; };
template <> struct EpiWantsUi<EpiPairI8> { static constexpr bool value = true; };
template <bool I8> struct AccSel { typedef f32x4 T; };
template <> struct AccSel<true> { typedef i32x4 T; };
__device__ __forceinline__ f32x4 mma1(bf16x8 a, bf16x8 b, f32x4 c) { return __builtin_amdgcn_mfma_f32_16x16x32_bf16(a, b, c, 0, 0, 0); }
__device__ __forceinline__ i32x4 mma1(bf16x8 a, bf16x8 b, i32x4 c) { return __builtin_amdgcn_mfma_i32_16x16x64_i8(__builtin_bit_cast(i32x4, a), __builtin_bit_cast(i32x4, b), c, 0, 0, 0); }
template <class Epi, class Sched, bool ALIGN_EPI = false, bool SP2 = false, bool I8 = false>
__device__ __forceinline__ void gemm_phase(PG8_LAS unsigned char* lds, const Gemm g, const Sched& S, const Epi& E) {
    const int tid = threadIdx.x, wid = __builtin_amdgcn_readfirstlane(tid >> 6), lane = tid & 63, wr = wid >> 2, wc = wid & 3, fr = lane & 15, fq = lane >> 4;
    const int K = g.K, nt = K / BK;
    unsigned voffA[2], voffB[2];
#pragma unroll
    for (int i = 0; i < 2; ++i) { int R, C; stage_rc(tid * 16 + i * 8192, R, C); const int Rb = Epi::PERM ? ((R & ~31) + perm32(R & 31)) : R;
        voffA[i] = (unsigned)(R * K + C) * 2u; voffB[i] = (unsigned)(Rb * K + C) * 2u; }
    const size_t kstep = (size_t)(BK * 2);
    const size_t hstep = (size_t)HALF * K * 2;
    const size_t tstep = 2 * hstep;
    const unsigned ldsw = (unsigned)wid * 1024u;
    const int aoff = lds_byte(wr * 64 + fr, fq * 8), boff = lds_byte(wc * 32 + fr, fq * 8);
#define PG8_SA(b, h) (((b) * 2 + (h)) * HTB)
#define PG8_SB(b, h) ((4 + (b) * 2 + (h)) * HTB)
#define PG8_STAGE(bufoff, gbase, voff) do { _Pragma("unroll") for (int _i = 0; _i < 2; ++_i) \
        __builtin_amdgcn_global_load_lds((const unsigned*)((const char*)(gbase) + (voff)[_i]), (PG8_LAS unsigned*)(lds + (bufoff) + ldsw + _i * 8192), 16, 0, 0); } while (0)
#define PG8_LDA(dst, b, h) do { _Pragma("unroll") for (int m = 0; m < 4; ++m) _Pragma("unroll") for (int k = 0; k < 2; ++k) dst[m][k] = *(const PG8_LAS bf16x8*)(lds + PG8_SA(b, h) + aoff + m * 2048 + k * 1024); } while (0)
#define PG8_LDB(dst, b, h) do { _Pragma("unroll") for (int n = 0; n < 2; ++n) _Pragma("unroll") for (int k = 0; k < 2; ++k) dst[n][k] = *(const PG8_LAS bf16x8*)(lds + PG8_SB(b, h) + boff + n * 2048 + k * 1024); } while (0)
#define PG8_MMA(ai, bj, At, Bt) do { __builtin_amdgcn_s_setprio(1); _Pragma("unroll") for (int m = 0; m < 4; ++m) _Pragma("unroll") for (int n = 0; n < 2; ++n) _Pragma("unroll") for (int k = 0; k < 2; ++k) \
        acc[ai][bj][m][n] = mma1(Bt[n][k], At[m][k], acc[ai][bj][m][n]); __builtin_amdgcn_s_setprio(0); } while (0)
#define PG8_WAIT_V(n) asm volatile("s_waitcnt vmcnt(" #n ")" ::: "memory")
#define PG8_WAIT_L(n) asm volatile("s_waitcnt lgkmcnt(" #n ")" ::: "memory")
#define PG8_BAR __builtin_amdgcn_s_barrier()
#define PG8_SCHED __builtin_amdgcn_sched_barrier(0)
    Unit cur, nxt; int ui = 0;
    if (!S.next(0, cur)) return;
    typedef typename AccSel<I8>::T AccT;
    AccT acc[2][2][4][2];
#pragma unroll
    for (int a = 0; a < 2; ++a)
#pragma unroll
        for (int b = 0; b < 2; ++b)
#pragma unroll
            for (int m = 0; m < 4; ++m)
#pragma unroll
                for (int n = 0; n < 2; ++n) acc[a][b][m][n] = (AccT){0, 0, 0, 0};
    bf16x8 At[4][2], B0[2][2], B1[2][2];
    const char* cA = (const char*)g.A + (size_t)cur.pm * tstep; const char* cB = (const char*)g.Bt + (size_t)cur.pn * tstep;
    S.a_ready(cur);
    if constexpr (SP2) {
        PG8_STAGE(PG8_SB(0, 0), cB, voffB); PG8_STAGE(PG8_SB(0, 1), cB + hstep, voffB); PG8_STAGE(PG8_SA(0, 0), cA, voffA); PG8_STAGE(PG8_SA(0, 1), cA + hstep, voffA);
        PG8_STAGE(PG8_SB(1, 0), cB + kstep, voffB); PG8_STAGE(PG8_SA(1, 0), cA + kstep, voffA); PG8_STAGE(PG8_SB(1, 1), cB + hstep + kstep, voffB);
        if (wr == 1) PG8_BAR;
        PG8_WAIT_V(8); PG8_BAR;
        PG8_WAIT_V(6); PG8_BAR;
    } else {
        PG8_STAGE(PG8_SB(0, 0), cB, voffB); PG8_STAGE(PG8_SA(0, 0), cA, voffA); PG8_STAGE(PG8_SB(0, 1), cB + hstep, voffB); PG8_STAGE(PG8_SA(0, 1), cA + hstep, voffA);
        if (wr == 1) PG8_BAR;
        PG8_WAIT_V(4); PG8_BAR;
        PG8_STAGE(PG8_SB(1, 0), cB + kstep, voffB); PG8_STAGE(PG8_SA(1, 0), cA + kstep, voffA); PG8_STAGE(PG8_SB(1, 1), cB + hstep + kstep, voffB);
        PG8_WAIT_V(6); PG8_BAR;
    }
    for (;;) {
        const bool has_next = S.next(ui + 1, nxt);
        const char* nA = has_next ? (const char*)g.A + (size_t)nxt.pm * tstep : cA; const char* nB = has_next ? (const char*)g.Bt + (size_t)nxt.pn * tstep : cB;
        for (int t = 0; t < nt; t += 2) {
            const bool last = (t == nt - 2);
            const char* a1 = cA + (size_t)(t + 1) * kstep;
            const char* a2 = last ? nA : cA + (size_t)(t + 2) * kstep; const char* b2 = last ? nB : cB + (size_t)(t + 2) * kstep;
            const char* a3 = a2 + kstep; const char* b3 = b2 + kstep;
            if (last && has_next) S.a_ready(nxt);
            if constexpr (SP2) {
            PG8_LDB(B0, 0, 0); PG8_LDB(B1, 0, 1); PG8_SCHED; PG8_LDA(At, 0, 0); PG8_STAGE(PG8_SA(1, 1), a1 + hstep, voffA);
            PG8_WAIT_V(8); PG8_WAIT_L(0); PG8_BAR; PG8_MMA(0, 0, At, B0); PG8_MMA(0, 1, At, B1); PG8_BAR; PG8_SCHED;
            PG8_LDA(At, 0, 1); PG8_STAGE(PG8_SB(0, 0), b2, voffB); PG8_STAGE(PG8_SB(0, 1), b2 + hstep, voffB); PG8_STAGE(PG8_SA(0, 0), a2, voffA);
            PG8_WAIT_V(8); PG8_WAIT_L(0); PG8_BAR; PG8_MMA(1, 0, At, B0); PG8_MMA(1, 1, At, B1); PG8_BAR; PG8_SCHED;
            PG8_LDB(B0, 1, 0); PG8_LDB(B1, 1, 1); PG8_SCHED; PG8_LDA(At, 1, 0); PG8_STAGE(PG8_SA(0, 1), a2 + hstep, voffA);
            PG8_WAIT_V(8); PG8_WAIT_L(0); PG8_BAR; PG8_MMA(0, 0, At, B0); PG8_MMA(0, 1, At, B1); PG8_BAR; PG8_SCHED;
            PG8_LDA(At, 1, 1); PG8_STAGE(PG8_SB(1, 0), b3, voffB); PG8_STAGE(PG8_SB(1, 1), b3 + hstep, voffB); PG8_STAGE(PG8_SA(1, 0), a3, voffA);
            PG8_WAIT_V(8); PG8_WAIT_L(0); PG8_BAR; PG8_MMA(1, 0, At, B0); PG8_MMA(1, 1, At, B1); PG8_BAR; PG8_SCHED;
            } else {
            PG8_LDB(B0, 0, 0); PG8_SCHED; PG8_LDA(At, 0, 0); PG8_STAGE(PG8_SA(1, 1), a1 + hstep, voffA);
            PG8_WAIT_L(8); PG8_BAR; PG8_WAIT_L(0); PG8_MMA(0, 0, At, B0); PG8_BAR; PG8_SCHED;
            PG8_LDB(B1, 0, 1); PG8_STAGE(PG8_SB(0, 0), b2, voffB);
            PG8_BAR; PG8_WAIT_L(0); PG8_MMA(0, 1, At, B1); PG8_BAR;
            PG8_LDA(At, 0, 1); PG8_STAGE(PG8_SA(0, 0), a2, voffA);
            PG8_BAR; PG8_WAIT_L(0); PG8_MMA(1, 0, At, B0); PG8_BAR; PG8_SCHED;
            PG8_STAGE(PG8_SB(0, 1), b2 + hstep, voffB);
            PG8_WAIT_V(6); PG8_BAR; PG8_MMA(1, 1, At, B1); PG8_BAR;
            PG8_LDB(B0, 1, 0); PG8_SCHED; PG8_LDA(At, 1, 0); PG8_STAGE(PG8_SA(0, 1), a2 + hstep, voffA);
            PG8_WAIT_L(8); PG8_BAR; PG8_WAIT_L(0); PG8_MMA(0, 0, At, B0); PG8_BAR; PG8_SCHED;
            PG8_LDB(B1, 1, 1); PG8_STAGE(PG8_SB(1, 0), b3, voffB);
            PG8_BAR; PG8_WAIT_L(0); PG8_MMA(0, 1, At, B1); PG8_BAR;
            PG8_LDA(At, 1, 1); PG8_STAGE(PG8_SA(1, 0), a3, voffA);
            PG8_BAR; PG8_WAIT_L(0); PG8_MMA(1, 0, At, B0); PG8_BAR; PG8_SCHED;
            PG8_STAGE(PG8_SB(1, 1), b3 + hstep, voffB);
            PG8_WAIT_V(6); PG8_BAR; PG8_MMA(1, 1, At, B1); PG8_BAR;
            }
        }
        if constexpr (ALIGN_EPI) { if (wr == 0) PG8_BAR; }
        if constexpr (!Epi::AFTER_DRAIN) { if constexpr (EpiWantsUi<Epi>::value) E(acc, cur, wr, wc, fr, fq, ui); else E(acc, cur, wr, wc, fr, fq); S.done(cur); }
        if (!has_next) break;
#pragma unroll
        for (int a = 0; a < 2; ++a)
#pragma unroll
            for (int b = 0; b < 2; ++b)
#pragma unroll
                for (int m = 0; m < 4; ++m)
#pragma unroll
                    for (int n = 0; n < 2; ++n) acc[a][b][m][n] = (AccT){0, 0, 0, 0};
        cur = nxt; cA = nA; cB = nB; ++ui;
        if constexpr (ALIGN_EPI) { if (wr == 1) PG8_BAR; }
    }
    PG8_WAIT_V(0);
    if constexpr (!ALIGN_EPI) { if (wr == 0) PG8_BAR; }
    PG8_BAR;
    if constexpr (Epi::AFTER_DRAIN) { E.fused(acc, cur, wr, wc, fr, fq, lds, wid, lane); S.done(cur); }
#undef PG8_SA
#undef PG8_SB
#undef PG8_STAGE
#undef PG8_LDA
#undef PG8_LDB
#undef PG8_MMA
#undef PG8_WAIT_V
#undef PG8_WAIT_L
#undef PG8_BAR
#undef PG8_SCHED
}
}

constexpr int NWAVES = 8;
constexpr int DM = 2048, SEQ = 4096, NB_P = 2, MP = NB_P * SEQ, MS = 32, MT = MP + MS;
constexpr int DFF = 5632, NGU = 2 * DFF;
constexpr int NH = 32, NKV = 4, HD = 64, QPK = 8, WIN = 128, NQKV = (NH + 2 * NKV) * HD;
constexpr int SSG = 16, SSN = 128, SSP = 64;
constexpr int GMC = 128, GMG = 16;
constexpr float EPS = 1e-6f;
constexpr float ATTN_SCALE = 0.125f;

constexpr size_t O_Y = 0;
constexpr size_t O_KP = (size_t)MT * DM;
constexpr size_t O_VP = O_KP + 65536;
constexpr size_t O_KS = O_VP + 65536;
constexpr size_t O_VS = O_KS + 1048576;
constexpr size_t O_CP = O_VS + 1048576;
constexpr size_t O_CS = O_CP + 8192;
constexpr size_t O_SRP = O_CS + 131072;
constexpr size_t O_SIP = O_SRP + 16384;
constexpr size_t O_SRS = O_SIP + 16384;
constexpr size_t O_SIS = O_SRS + 262144;
constexpr size_t O_GV = O_SIS + 262144;
constexpr size_t O_END = O_GV + 65536;

constexpr size_t MiB = 1u << 20;
constexpr size_t WS_CTL = 0, CTL_ZERO_BYTES = 1 * MiB;
constexpr size_t SZ_WGU = (size_t)NGU * DM  , SZ_WDN = (size_t)DM * DFF * 2, SZ_SQ = (size_t)DM * DM * 2;
constexpr size_t WS_WGU = 2 * MiB;
constexpr size_t WS_WDN = WS_WGU + 8 * SZ_WGU;
constexpr size_t WS_WQKV = WS_WDN + 8 * SZ_WDN;
constexpr size_t WS_WO = WS_WQKV + (size_t)NQKV * DM * 2;
constexpr size_t WS_WCIN = WS_WO + SZ_SQ;
constexpr size_t WS_WCOUT = WS_WCIN + 3 * SZ_SQ;
constexpr size_t WS_WGATE = WS_WCOUT + SZ_SQ;
constexpr size_t WS_WUV = WS_WGATE + SZ_SQ;
constexpr size_t WS_WGOUT = WS_WUV + 2 * SZ_SQ;
constexpr size_t WS_WS = WS_WGOUT + SZ_SQ;
constexpr size_t SZ_ROWS = (size_t)(MT + 224) * DM * 2;
constexpr size_t WS_H = ((WS_WS + (size_t)GMG * GMC * GMC * 2 + MiB - 1) / MiB) * MiB;
constexpr size_t WS_T0 = WS_H + SZ_ROWS, WS_T1 = WS_T0 + SZ_ROWS, WS_T2 = WS_T1 + SZ_ROWS;
constexpr size_t WS_KB = WS_T2 + SZ_ROWS;
constexpr size_t WS_VB = WS_KB + (size_t)(MT + 224) * 256 * 2;
constexpr size_t WS_ACT = WS_VB + (size_t)(MT + 224) * 256 * 2;
constexpr size_t WS_D = WS_ACT + (size_t)(MT + 224) * DFF * 2;
constexpr size_t WS_HQ = WS_D + (size_t)(MT + 224) * DM * 4;
constexpr size_t WS_RS = WS_HQ + (size_t)(MT + 224) * DM;
constexpr size_t WS_CS = WS_RS + (size_t)(MT + 224) * 4;
constexpr size_t WS_P = WS_CS + (size_t)8 * NGU * 4;
constexpr size_t WS_X = WS_P + (size_t)4 * MS * 6144 * 4;
constexpr size_t WS_END = WS_X + (size_t)(MT + 224) * DM * 2;
constexpr int CW_BAR = 4096;

constexpr int RING_OFF = 0, RING_BYTES = 131072;
constexpr int LDSCTL_OFF = RING_BYTES, MISC_OFF = LDSCTL_OFF + 320;
constexpr int SC_OFF = MISC_OFF + 64, SC_BYTES = 6 * 512 * 4;
constexpr int LDS_BYTES = 147456;
static_assert(SC_OFF % 16 == 0 && SC_OFF + SC_BYTES <= LDS_BYTES, "scale table");

#define GAS __attribute__((address_space(1)))
#define LAS __attribute__((address_space(3)))
typedef unsigned short bf16;
typedef unsigned v4u __attribute__((ext_vector_type(4)));
typedef unsigned v2u __attribute__((ext_vector_type(2)));
typedef float f32x4 __attribute__((ext_vector_type(4)));
typedef float f32x16 __attribute__((ext_vector_type(16)));
typedef int i32x4 __attribute__((ext_vector_type(4)));
typedef int i32x16 __attribute__((ext_vector_type(16)));
typedef short bf16x8 __attribute__((ext_vector_type(8)));
typedef GAS unsigned gu32;
#define RLX_AGENT __ATOMIC_RELAXED, __HIP_MEMORY_SCOPE_AGENT
#define LDS_WAIT() asm volatile("s_waitcnt lgkmcnt(0)" ::: "memory")
#define VM_WAIT() asm volatile("s_waitcnt vmcnt(0)" ::: "memory")
using pg8::cvt_pk_bf16; using pg8::bf2f; using pg8::gelu_tanh_f; using pg8::gelu_tanh_pk; using pg8::f32x2_t; using pg8::fast_sigmoid; using pg8::silu_f;
__device__ __forceinline__ unsigned short f2bf(float f) { return (unsigned short)(cvt_pk_bf16(f, 0.f) & 0xffffu); }
#define XB_TMO      128
#define XB_XCNT(j)  (256  + 64 * (j))
#define XB_XSUB(j)  (1280 + 64 * (j))
#define XB_XGEN(j)  (2304 + 64 * (j))
#define XB_TOP      3328
#define XB_TOPGEN   3392
#define XCD_BAR_WORDS 3456
#define XB_SPIN_CAP (1u << 18)

__device__ __forceinline__ unsigned xb_ld(unsigned* p)              { return __hip_atomic_load(p, __ATOMIC_RELAXED, __HIP_MEMORY_SCOPE_AGENT); }
__device__ __forceinline__ unsigned xb_add(unsigned* p, unsigned v) { return __hip_atomic_fetch_add(p, v, __ATOMIC_RELAXED, __HIP_MEMORY_SCOPE_AGENT); }
__device__ __forceinline__ unsigned xb_xcc_id() { return (unsigned)__builtin_amdgcn_s_getreg((3 << 11) | 20) & 0xFu; }
#define XB_SPIN(cond, bar) do { unsigned _sp = 0; while (cond) { __builtin_amdgcn_s_sleep(1); \
    if ((++_sp & 255u) == 0u) { if (xb_ld(&(bar)[XB_TMO])) break; if (_sp > XB_SPIN_CAP) { atomicAdd(&(bar)[XB_TMO], 1u); break; } } } } while (0)

struct XcdBarrier {
    unsigned* bar; unsigned x;
    volatile LAS unsigned* st;
};

__device__ __forceinline__ XcdBarrier xcd_barrier_post(unsigned* bar, volatile LAS unsigned* st) {
    XcdBarrier b; b.bar = bar; b.x = xb_xcc_id(); b.st = st;
    if (threadIdx.x == 0) (void)xb_add(&bar[XB_XCNT(b.x)], 1u);
    return b;
}
__device__ __forceinline__ void xcd_barrier_complete(unsigned* bar, unsigned x, unsigned& nloc, unsigned& nx) {
    const unsigned G = gridDim.x * gridDim.y * gridDim.z;
    unsigned sum, cnt, mine, sp = 0u;
    for (;;) {
        sum = 0u; cnt = 0u; mine = 0u;
#pragma unroll
        for (unsigned j = 0; j < 16; ++j) { const unsigned c = xb_ld(&bar[XB_XCNT(j)]); sum += c; cnt += (c > 0u) ? 1u : 0u; mine = (j == x) ? c : mine; }
        if (sum == G) break;
        __builtin_amdgcn_s_sleep(1);
        if ((++sp & 255u) == 0u) { if (xb_ld(&bar[XB_TMO])) break; if (sp > XB_SPIN_CAP) { atomicAdd(&bar[XB_TMO], 1u); break; } }
    }
    nloc = mine > 0u ? mine : 1u; nx = cnt > 0u ? cnt : 1u;
}

__device__ __forceinline__ void xcd_barrier(const XcdBarrier& b) {
    asm volatile("s_waitcnt vmcnt(0)" ::: "memory");
    __builtin_amdgcn_s_waitcnt(0x0F70);
    __syncthreads();
    if (threadIdx.x == 0) {
        unsigned* bar = b.bar;
        __builtin_amdgcn_s_waitcnt(0);
        unsigned nloc = b.st[0], nx = b.st[1];
        if (nloc == 0u) { xcd_barrier_complete(bar, b.x, nloc, nx); b.st[0] = nloc; b.st[1] = nx; }
        const unsigned old = xb_add(&bar[XB_XSUB(b.x)], 1u);
        const unsigned gen = old / nloc;
        if (old + 1u == (gen + 1u) * nloc) {
            __builtin_amdgcn_fence(__ATOMIC_RELEASE, "agent");
            asm volatile("s_waitcnt vmcnt(0)" ::: "memory");
            const unsigned og = xb_add(&bar[XB_TOP], 1u);
            const unsigned tg = og / nx;
            if (og + 1u == (tg + 1u) * nx) xb_add(&bar[XB_TOPGEN], 1u);
            else XB_SPIN(xb_ld(&bar[XB_TOPGEN]) == tg, bar);
            __builtin_amdgcn_fence(__ATOMIC_ACQUIRE, "agent");
            xb_add(&bar[XB_XGEN(b.x)], 1u);
            asm volatile("s_waitcnt vmcnt(0)" ::: "memory");
        } else {
            XB_SPIN(xb_ld(&bar[XB_XGEN(b.x)]) == gen, bar);
            __builtin_amdgcn_fence(__ATOMIC_ACQUIRE, "agent");
            asm volatile("s_waitcnt vmcnt(0)" ::: "memory");
        }
    }
    __syncthreads();
}

struct Frame {
    LAS unsigned char* lds;
    volatile LAS unsigned* MISC;
    int tid, lane, wave;
    int vcu, G;
    unsigned char* ws;
    float* out;
};
__device__ __forceinline__ float wave_sum(float v) {
#pragma unroll
    for (int o = 1; o < 64; o <<= 1) v += __shfl_xor(v, o);
    return v;
}
__device__ __forceinline__ float wave_max(float v) {
#pragma unroll
    for (int o = 1; o < 64; o <<= 1) v = fmaxf(v, __shfl_xor(v, o));
    return v;
}

__device__ __forceinline__ void cvt_item(const float* W, int K, int N, bf16* WT, int k0, int n0, int drow, LAS float* scr, int lane) {
    f32x4 v[8];
#pragma unroll
    for (int i = 0; i < 8; ++i) { const int kk = 8 * i + (lane >> 3); v[i] = __builtin_nontemporal_load((const f32x4*)(W + (size_t)(k0 + kk) * N + n0 + 4 * (lane & 7))); }
#pragma unroll
    for (int i = 0; i < 8; ++i) { const int kk = 8 * i + (lane >> 3); LAS float* d = scr + kk * 33 + 4 * (lane & 7); d[0] = v[i].x; d[1] = v[i].y; d[2] = v[i].z; d[3] = v[i].w; }
    LDS_WAIT(); asm volatile("" ::: "memory");
    const int c = lane & 7;
#pragma unroll
    for (int j = 0; j < 4; ++j) { const int n = (lane >> 3) + 8 * j; const LAS float* s = scr + (8 * c) * 33 + n;
        v4u o; o.x = cvt_pk_bf16(s[0 * 33], s[1 * 33]); o.y = cvt_pk_bf16(s[2 * 33], s[3 * 33]); o.z = cvt_pk_bf16(s[4 * 33], s[5 * 33]); o.w = cvt_pk_bf16(s[6 * 33], s[7 * 33]);
        *(GAS v4u*)(WT + (size_t)(drow + n) * K + k0 + 8 * c) = o; }
    LDS_WAIT(); asm volatile("" ::: "memory");
}
__device__ __forceinline__ int map_plain(int n0) { return n0; }
__device__ __forceinline__ int map_gu(int n0) { const int half = n0 >= DFF ? 1 : 0, j = n0 - half * DFF; return 256 * (j >> 7) + 128 * half + (j & 127); }
__device__ __forceinline__ int map_cin(int n0) { if (n0 < DM) return 2 * DM + n0; const int q = (n0 - DM) >= DM ? 1 : 0, j = n0 - DM - q * DM; return 256 * (j >> 7) + 128 * q + (j & 127); }

struct In { const float* p[32]; };

enum CvtJob { CJ_GU = 0, CJ_DN = 8, CJ_QKV = 16, CJ_O, CJ_CIN, CJ_COUT, CJ_GATE, CJ_UV, CJ_GOUT };
__device__ __forceinline__ void cvt_job(Frame& F, const In& in, int job, int wi, int nw) {
    LAS float* scr = (LAS float*)(F.lds + RING_OFF + F.wave * 16384);
    const float* src; bf16* dst; int K, N, kind = 0;
    if (job < 8) { src = in.p[8] + (size_t)job * DM * NGU; dst = (bf16*)(F.ws + WS_WGU + job * SZ_WGU); K = DM; N = NGU; kind = 1; }
    else if (job < 16) { src = in.p[9] + (size_t)(job - 8) * DFF * DM; dst = (bf16*)(F.ws + WS_WDN + (job - 8) * SZ_WDN); K = DFF; N = DM; }
    else if (job == CJ_QKV) { src = in.p[10]; dst = (bf16*)(F.ws + WS_WQKV); K = DM; N = NQKV; }
    else if (job == CJ_O) { src = in.p[11]; dst = (bf16*)(F.ws + WS_WO); K = DM; N = DM; }
    else if (job == CJ_CIN) { src = in.p[13]; dst = (bf16*)(F.ws + WS_WCIN); K = DM; N = 3 * DM; kind = 2; }
    else if (job == CJ_COUT) { src = in.p[15]; dst = (bf16*)(F.ws + WS_WCOUT); K = DM; N = DM; }
    else if (job == CJ_GATE) { src = in.p[24]; dst = (bf16*)(F.ws + WS_WGATE); K = DM; N = DM; }
    else if (job == CJ_UV) { src = in.p[26]; dst = (bf16*)(F.ws + WS_WUV); K = DM; N = 2 * DM; }
    else { src = in.p[31]; dst = (bf16*)(F.ws + WS_WGOUT); K = DM; N = DM; }
    const int nblk = N / 32, nitems = (K / 64) * nblk;
    for (int it = wi; it < nitems; it += nw) { const int kb = it / nblk, nb = it - kb * nblk, n0 = 32 * nb;
        const int drow = kind == 1 ? map_gu(n0) : kind == 2 ? map_cin(n0) : n0;
        cvt_item(src, K, N, dst, 64 * kb, n0, drow, scr, F.lane); }
}
__device__ __forceinline__ void cvt_gu_strip(Frame& F, const float* W, signed char* Bq, float* cs, int n0) {
    LAS float* red = (LAS float*)(F.lds + RING_OFF);
    LAS unsigned* tile = (LAS unsigned*)(F.lds + RING_OFF + 2048);
    const int c = F.tid & 31, kg = F.tid >> 5, drow = map_gu(n0);
    float v[32][4]; float am = 0.f;
#pragma unroll
    for (int i = 0; i < 32; ++i)
#pragma unroll
        for (int e = 0; e < 4; ++e) v[i][e] = __builtin_nontemporal_load(W + (size_t)(64 * i + 4 * kg + e) * NGU + n0 + c);
#pragma unroll
    for (int i = 0; i < 32; ++i) am = fmaxf(am, fmaxf(fmaxf(fabsf(v[i][0]), fabsf(v[i][1])), fmaxf(fabsf(v[i][2]), fabsf(v[i][3]))));
    red[kg * 32 + c] = am;
    __syncthreads();
    float cm = 0.f;
#pragma unroll
    for (int k = 0; k < 16; ++k) cm = fmaxf(cm, red[k * 32 + c]);
    const float inv = cm > 0.f ? 127.f / cm : 0.f;
    if (kg == 0) cs[drow + c] = cm > 0.f ? cm * (1.f / 127.f) : 1.f;
#pragma unroll
    for (int i = 0; i < 32; ++i) {
        const float qa = fmaf(v[i][0], inv, 12582912.f), qb = fmaf(v[i][1], inv, 12582912.f), qc = fmaf(v[i][2], inv, 12582912.f), qd = fmaf(v[i][3], inv, 12582912.f);
        unsigned w = __builtin_amdgcn_perm(__builtin_bit_cast(unsigned, qb), __builtin_bit_cast(unsigned, qa), 0x0c0c0400u);
        w = __builtin_amdgcn_perm(__builtin_bit_cast(unsigned, qc), w, 0x0c040100u);
        w = __builtin_amdgcn_perm(__builtin_bit_cast(unsigned, qd), w, 0x04020100u);
        tile[c * 513 + 16 * i + kg] = w; }
    __syncthreads();
#pragma unroll
    for (int j = 0; j < 8; ++j) { const int qd = F.tid + 512 * j, row = qd >> 7, ch = qd & 127; const LAS unsigned* t = tile + row * 513 + 4 * ch;
        v4u w; w.x = t[0]; w.y = t[1]; w.z = t[2]; w.w = t[3];
        *(GAS v4u*)(Bq + (size_t)(drow + row) * DM + 16 * ch) = w; }
    __syncthreads();
}
__device__ __forceinline__ void cvt_gu_all(Frame& F, const In& in, int j0, int j1, int wg, int nwg) {
    constexpr int SPM = NGU / 32;
    for (int sid = j0 * SPM + wg; sid < j1 * SPM; sid += nwg) { const int j = sid / SPM, nb = sid - j * SPM;
        cvt_gu_strip(F, in.p[8] + (size_t)j * DM * NGU, (signed char*)(F.ws + WS_WGU + j * SZ_WGU), (float*)(F.ws + WS_CS) + (size_t)j * NGU, 32 * nb); }
}
__device__ __forceinline__ void p0_convert(Frame& F, const In& in) {
    const int gw = F.vcu * NWAVES + F.wave, NGW = F.G * NWAVES;
    cvt_gu_all(F, in, 0, 8, F.vcu, F.G);
    cvt_job(F, in, CJ_QKV, gw, NGW); cvt_job(F, in, CJ_GATE, gw, NGW); cvt_job(F, in, CJ_UV, gw, NGW); cvt_job(F, in, CJ_GOUT, gw, NGW);
    { const float* wsrc = in.p[29]; bf16* wd = (bf16*)(F.ws + WS_WS);
      for (int i = (F.vcu * NWAVES * 64 + F.tid); i < GMG * GMC * GMC; i += F.G * NWAVES * 64) { const int t = (i >> 7) & 127, s = i & 127; wd[i] = (s <= t) ? f2bf(wsrc[i]) : (bf16)0; } }
}

__device__ __forceinline__ float h2f(unsigned short b) { return (float)__builtin_bit_cast(_Float16, b); }
__device__ __forceinline__ unsigned pk_f16(float lo, float hi) { return (unsigned)__builtin_bit_cast(unsigned short, (_Float16)lo) | ((unsigned)__builtin_bit_cast(unsigned short, (_Float16)hi) << 16); }
template <bool HAS_D, bool XIN_F32 = false, bool XOUT_F32 = false>
__device__ __forceinline__ void resid_norm_rows(Frame& F, const float* xin_p, const float* xin_s, bf16* xb, float* xout, const bf16* Dm, float alpha, const float* g_post, const float* g_pre, bf16* H, unsigned* Hq = nullptr, float* rs = nullptr,
                                                const float* PS = nullptr, int nsl = 0, const bf16* gz = nullptr, const float* gb = nullptr, int row_begin = 0) {
    const int gw0 = F.vcu * NWAVES + F.wave, NGW = F.G * NWAVES;
    const bool spread = (row_begin == MP) && (NGW % MS == 0);
    const int gw = spread ? ((gw0 % (NGW / MS) == 0) ? gw0 / (NGW / MS) : MT) : gw0;
    for (int row0 = row_begin + gw; row0 < MT; row0 += 2 * NGW) {
        const int row1 = row0 + NGW; const bool two = row1 < MT;
        const int rr[2] = {row0, two ? row1 : row0};
        f32x4 xv[2][8]; v2u dw[2][8];
#pragma unroll
        for (int k = 0; k < 2; ++k) { const int row = rr[k];
            if (XIN_F32) { const float* xr = (row < MP) ? xin_p + (size_t)row * DM : xin_s + (size_t)(row - MP) * DM;
#pragma unroll
                for (int j = 0; j < 8; ++j) xv[k][j] = ((const GAS f32x4*)xr)[F.lane + 64 * j];
            } else {
#pragma unroll
                for (int j = 0; j < 8; ++j) { const v2u w = ((const GAS v2u*)(xb + (size_t)row * DM))[F.lane + 64 * j];
                    xv[k][j].x = h2f((bf16)(w.x & 0xffffu)); xv[k][j].y = h2f((bf16)(w.x >> 16)); xv[k][j].z = h2f((bf16)(w.y & 0xffffu)); xv[k][j].w = h2f((bf16)(w.y >> 16)); } }
            if (HAS_D) {
#pragma unroll
                for (int j = 0; j < 8; ++j) dw[k][j] = ((const GAS v2u*)(Dm + (size_t)row * DM))[F.lane + 64 * j]; } }
#pragma unroll
        for (int k = 0; k < 2; ++k) { const int row = rr[k]; if (k == 1 && !two) break;
            if (HAS_D) {
                f32x4 dv[8]; float ss = 0.f;
                if (PS != nullptr && row >= MP) {
#pragma unroll
                    for (int j = 0; j < 8; ++j) { f32x4 a = (f32x4){0.f, 0.f, 0.f, 0.f};
                        for (int sl = 0; sl < nsl; ++sl) a = a + ((const GAS f32x4*)(PS + ((size_t)sl * MS + (row - MP)) * DM))[F.lane + 64 * j];
                        if (gz != nullptr) { const f32x4 bb = ((const GAS f32x4*)gb)[F.lane + 64 * j]; const v2u zw = ((const GAS v2u*)(gz + (size_t)row * DM))[F.lane + 64 * j];
                            a.x = bf2f((bf16)(zw.x & 0xffffu)) * fast_sigmoid(a.x + bb.x); a.y = bf2f((bf16)(zw.x >> 16)) * fast_sigmoid(a.y + bb.y);
                            a.z = bf2f((bf16)(zw.y & 0xffffu)) * fast_sigmoid(a.z + bb.z); a.w = bf2f((bf16)(zw.y >> 16)) * fast_sigmoid(a.w + bb.w); }
                        dv[j] = a; ss += (a.x * a.x + a.y * a.y) + (a.z * a.z + a.w * a.w); }
                } else {
#pragma unroll
                for (int j = 0; j < 8; ++j) { const v2u w = dw[k][j];
                    dv[j].x = bf2f((bf16)(w.x & 0xffffu)); dv[j].y = bf2f((bf16)(w.x >> 16)); dv[j].z = bf2f((bf16)(w.y & 0xffffu)); dv[j].w = bf2f((bf16)(w.y >> 16));
                    ss += (dv[j].x * dv[j].x + dv[j].y * dv[j].y) + (dv[j].z * dv[j].z + dv[j].w * dv[j].w); }
                }
                f32x4 gpo[8];
#pragma unroll
                for (int j = 0; j < 8; ++j) gpo[j] = ((const GAS f32x4*)g_post)[F.lane + 64 * j];
                const float rstd = alpha * __builtin_amdgcn_rsqf(wave_sum(ss) * (1.f / DM) + EPS);
#pragma unroll
                for (int j = 0; j < 8; ++j) { const f32x4 g = gpo[j]; xv[k][j] = xv[k][j] + dv[j] * g * rstd; }
            }
            if (XOUT_F32) {
#pragma unroll
                for (int j = 0; j < 8; ++j) ((GAS f32x4*)(xout + (size_t)row * DM))[F.lane + 64 * j] = xv[k][j];
            } else {
#pragma unroll
                for (int j = 0; j < 8; ++j) { v2u w; w.x = pk_f16(xv[k][j].x, xv[k][j].y); w.y = pk_f16(xv[k][j].z, xv[k][j].w); ((GAS v2u*)(xb + (size_t)row * DM))[F.lane + 64 * j] = w;
                    xv[k][j].x = h2f((bf16)(w.x & 0xffffu)); xv[k][j].y = h2f((bf16)(w.x >> 16)); xv[k][j].z = h2f((bf16)(w.y & 0xffffu)); xv[k][j].w = h2f((bf16)(w.y >> 16)); }
            }
            if (g_pre) {
                f32x4 gpr[8];
#pragma unroll
                for (int j = 0; j < 8; ++j) gpr[j] = ((const GAS f32x4*)g_pre)[F.lane + 64 * j];
                float ss = 0.f;
#pragma unroll
                for (int j = 0; j < 8; ++j) ss += (xv[k][j].x * xv[k][j].x + xv[k][j].y * xv[k][j].y) + (xv[k][j].z * xv[k][j].z + xv[k][j].w * xv[k][j].w);
                const float rstd = __builtin_amdgcn_rsqf(wave_sum(ss) * (1.f / DM) + EPS);
                if (Hq == nullptr) {
#pragma unroll
                    for (int j = 0; j < 8; ++j) { const f32x4 g = gpr[j]; const f32x4 o = xv[k][j] * g * rstd;
                        v2u w; w.x = cvt_pk_bf16(o.x, o.y); w.y = cvt_pk_bf16(o.z, o.w); ((GAS v2u*)(H + (size_t)row * DM))[F.lane + 64 * j] = w; }
                } else {
                    float am = 0.f;
#pragma unroll
                    for (int j = 0; j < 8; ++j) { const f32x4 g = gpr[j]; xv[k][j] = xv[k][j] * g * rstd;
                        am = fmaxf(am, fmaxf(fmaxf(fabsf(xv[k][j].x), fabsf(xv[k][j].y)), fmaxf(fabsf(xv[k][j].z), fabsf(xv[k][j].w)))); }
                    am = wave_max(am); const float inv = am > 0.f ? 127.f / am : 0.f;
                    if (F.lane == 0) rs[row] = am > 0.f ? am * (1.f / 127.f) : 1.f;
#pragma unroll
                    for (int j = 0; j < 8; ++j) { const int q0 = (int)rintf(xv[k][j].x * inv), q1 = (int)rintf(xv[k][j].y * inv), q2 = (int)rintf(xv[k][j].z * inv), q3 = (int)rintf(xv[k][j].w * inv);
                        ((GAS unsigned*)(Hq + (size_t)row * (DM / 4)))[F.lane + 64 * j] = (unsigned)(q0 & 0xff) | ((unsigned)(q1 & 0xff) << 8) | ((unsigned)(q2 & 0xff) << 16) | ((unsigned)(q3 & 0xff) << 24); }
                }
            }
        }
    }
}

#define DPPF(old_, src_, ctrl_, rmask_) __builtin_bit_cast(float, __builtin_amdgcn_update_dpp(__builtin_bit_cast(int, (float)(old_)), __builtin_bit_cast(int, (float)(src_)), (ctrl_), (rmask_), 0xf, false))
__device__ __forceinline__ float wave_sum_dpp(float v) {
    v += DPPF(0.f, v, 0xB1, 0xf); v += DPPF(0.f, v, 0x4E, 0xf); v += DPPF(0.f, v, 0x141, 0xf); v += DPPF(0.f, v, 0x140, 0xf);
    v += DPPF(0.f, v, 0x142, 0xa); v += DPPF(0.f, v, 0x143, 0xc);
    return __builtin_bit_cast(float, __builtin_amdgcn_readlane(__builtin_bit_cast(int, v), 63));
}
__device__ __forceinline__ float wave_max_dpp(float v) {
    v = fmaxf(v, DPPF(0.f, v, 0xB1, 0xf)); v = fmaxf(v, DPPF(0.f, v, 0x4E, 0xf)); v = fmaxf(v, DPPF(0.f, v, 0x141, 0xf)); v = fmaxf(v, DPPF(0.f, v, 0x140, 0xf));
    v = fmaxf(v, DPPF(0.f, v, 0x142, 0xa)); v = fmaxf(v, DPPF(0.f, v, 0x143, 0xc));
    return __builtin_bit_cast(float, __builtin_amdgcn_readlane(__builtin_bit_cast(int, v), 63));
}
template <bool XOUT_F32>
__device__ __forceinline__ void resid_norm_sample(Frame& F, bf16* xb, float* xout, float alpha, const float* g_post, const float* g_pre, bf16* H, unsigned* Hq, float* rs, const float* PS, const bf16* gz, const float* gb) {
    const int gw0 = F.vcu * NWAVES + F.wave, NGW = F.G * NWAVES, lane = F.lane;
    const bool spread = (NGW % MS == 0);
    const int sidx = spread ? ((gw0 % (NGW / MS) == 0) ? gw0 / (NGW / MS) : MS) : gw0;
    if (sidx >= MS) return;
    const int row = MP + sidx;
    f32x4 dv[8]; v2u xw[8];
    {   f32x4 ps[4][8];
#pragma unroll
        for (int sl = 0; sl < 4; ++sl)
#pragma unroll
            for (int j = 0; j < 8; ++j) ps[sl][j] = ((const GAS f32x4*)(PS + ((size_t)sl * MS + sidx) * DM))[lane + 64 * j];
#pragma unroll
        for (int j = 0; j < 8; ++j) xw[j] = ((const GAS v2u*)(xb + (size_t)row * DM))[lane + 64 * j];
#pragma unroll
        for (int j = 0; j < 8; ++j) dv[j] = (ps[0][j] + ps[1][j]) + (ps[2][j] + ps[3][j]); }
    if (gz != nullptr) {
        f32x4 bb[8]; v2u zw[8];
#pragma unroll
        for (int j = 0; j < 8; ++j) { bb[j] = ((const GAS f32x4*)gb)[lane + 64 * j]; zw[j] = ((const GAS v2u*)(gz + (size_t)row * DM))[lane + 64 * j]; }
#pragma unroll
        for (int j = 0; j < 8; ++j) { f32x4 a = dv[j]; const v2u z = zw[j];
            a.x = bf2f((bf16)(z.x & 0xffffu)) * fast_sigmoid(a.x + bb[j].x); a.y = bf2f((bf16)(z.x >> 16)) * fast_sigmoid(a.y + bb[j].y);
            a.z = bf2f((bf16)(z.y & 0xffffu)) * fast_sigmoid(a.z + bb[j].z); a.w = bf2f((bf16)(z.y >> 16)) * fast_sigmoid(a.w + bb[j].w); dv[j] = a; } }
    float ss = 0.f;
#pragma unroll
    for (int j = 0; j < 8; ++j) ss += (dv[j].x * dv[j].x + dv[j].y * dv[j].y) + (dv[j].z * dv[j].z + dv[j].w * dv[j].w);
    f32x4 xv[8];
    {   f32x4 gpo[8];
#pragma unroll
        for (int j = 0; j < 8; ++j) gpo[j] = ((const GAS f32x4*)g_post)[lane + 64 * j];
        const float rstd = alpha * __builtin_amdgcn_rsqf(wave_sum_dpp(ss) * (1.f / DM) + EPS);
#pragma unroll
        for (int j = 0; j < 8; ++j) { const v2u w = xw[j]; f32x4 x0; x0.x = h2f((bf16)(w.x & 0xffffu)); x0.y = h2f((bf16)(w.x >> 16)); x0.z = h2f((bf16)(w.y & 0xffffu)); x0.w = h2f((bf16)(w.y >> 16));
            xv[j] = x0 + dv[j] * gpo[j] * rstd; } }
    f32x4 gpr[8];
    if (g_pre) {
#pragma unroll
        for (int j = 0; j < 8; ++j) gpr[j] = ((const GAS f32x4*)g_pre)[lane + 64 * j]; }
    if (XOUT_F32) {
#pragma unroll
        for (int j = 0; j < 8; ++j) ((GAS f32x4*)(xout + (size_t)row * DM))[lane + 64 * j] = xv[j];
    } else {
#pragma unroll
        for (int j = 0; j < 8; ++j) { v2u w; w.x = pk_f16(xv[j].x, xv[j].y); w.y = pk_f16(xv[j].z, xv[j].w); ((GAS v2u*)(xb + (size_t)row * DM))[lane + 64 * j] = w; } }
    if (g_pre) {
        float s2 = 0.f;
#pragma unroll
        for (int j = 0; j < 8; ++j) s2 += (xv[j].x * xv[j].x + xv[j].y * xv[j].y) + (xv[j].z * xv[j].z + xv[j].w * xv[j].w);
        const float rstd2 = __builtin_amdgcn_rsqf(wave_sum_dpp(s2) * (1.f / DM) + EPS);
        if (Hq == nullptr) {
#pragma unroll
            for (int j = 0; j < 8; ++j) { const f32x4 o = xv[j] * gpr[j] * rstd2; v2u w; w.x = cvt_pk_bf16(o.x, o.y); w.y = cvt_pk_bf16(o.z, o.w); ((GAS v2u*)(H + (size_t)row * DM))[lane + 64 * j] = w; }
        } else {
            float am = 0.f;
#pragma unroll
            for (int j = 0; j < 8; ++j) { xv[j] = xv[j] * gpr[j] * rstd2; am = fmaxf(am, fmaxf(fmaxf(fabsf(xv[j].x), fabsf(xv[j].y)), fmaxf(fabsf(xv[j].z), fabsf(xv[j].w)))); }
            am = wave_max_dpp(am); const float inv = am > 0.f ? 127.f / am : 0.f;
            if (lane == 0) rs[row] = am > 0.f ? am * (1.f / 127.f) : 1.f;
#pragma unroll
            for (int j = 0; j < 8; ++j) { const int q0 = (int)rintf(xv[j].x * inv), q1 = (int)rintf(xv[j].y * inv), q2 = (int)rintf(xv[j].z * inv), q3 = (int)rintf(xv[j].w * inv);
                ((GAS unsigned*)(Hq + (size_t)row * (DM / 4)))[lane + 64 * j] = (unsigned)(q0 & 0xff) | ((unsigned)(q1 & 0xff) << 8) | ((unsigned)(q2 & 0xff) << 16) | ((unsigned)(q3 & 0xff) << 24); }
        }
    }
}
template <bool XOUT_F32>
__device__ __forceinline__ void resid_norm_sample_wg(Frame& F, bf16* xb, float* xout, float alpha, const float* g_post, const float* g_pre, bf16* H, unsigned* Hq, float* rs, const float* PS, const bf16* gz, const float* gb) {
    if (F.G % MS != 0) { resid_norm_sample<XOUT_F32>(F, xb, xout, alpha, g_post, g_pre, H, Hq, rs, PS, gz, gb); return; }
    const int per = F.G / MS;
    if (F.vcu % per != 0) return;
    const int sidx = F.vcu / per, row = MP + sidx, t = F.tid;
    LAS float* red = (LAS float*)(F.lds + RING_OFF);
    f32x4 ps[4];
#pragma unroll
    for (int sl = 0; sl < 4; ++sl) ps[sl] = ((const GAS f32x4*)(PS + ((size_t)sl * MS + sidx) * DM))[t];
    const v2u xw = ((const GAS v2u*)(xb + (size_t)row * DM))[t];
    const f32x4 gpo = ((const GAS f32x4*)g_post)[t];
    f32x4 gpr = (f32x4){0.f, 0.f, 0.f, 0.f}; if (g_pre) gpr = ((const GAS f32x4*)g_pre)[t];
    f32x4 bb = (f32x4){0.f, 0.f, 0.f, 0.f}; v2u zw = (v2u){0u, 0u};
    if (gz != nullptr) { bb = ((const GAS f32x4*)gb)[t]; zw = ((const GAS v2u*)(gz + (size_t)row * DM))[t]; }
    f32x4 dv = (ps[0] + ps[1]) + (ps[2] + ps[3]);
    if (gz != nullptr) { dv.x = bf2f((bf16)(zw.x & 0xffffu)) * fast_sigmoid(dv.x + bb.x); dv.y = bf2f((bf16)(zw.x >> 16)) * fast_sigmoid(dv.y + bb.y);
        dv.z = bf2f((bf16)(zw.y & 0xffffu)) * fast_sigmoid(dv.z + bb.z); dv.w = bf2f((bf16)(zw.y >> 16)) * fast_sigmoid(dv.w + bb.w); }
    { const float w = wave_sum_dpp((dv.x * dv.x + dv.y * dv.y) + (dv.z * dv.z + dv.w * dv.w)); if (F.lane == 0) red[F.wave] = w; }
    __syncthreads();
    float ss = 0.f;
#pragma unroll
    for (int w = 0; w < 8; ++w) ss += red[w];
    const float rstd = alpha * __builtin_amdgcn_rsqf(ss * (1.f / DM) + EPS);
    f32x4 x0; x0.x = h2f((bf16)(xw.x & 0xffffu)); x0.y = h2f((bf16)(xw.x >> 16)); x0.z = h2f((bf16)(xw.y & 0xffffu)); x0.w = h2f((bf16)(xw.y >> 16));
    f32x4 xv = x0 + dv * gpo * rstd;
    if (XOUT_F32) ((GAS f32x4*)(xout + (size_t)row * DM))[t] = xv;
    else { v2u w; w.x = pk_f16(xv.x, xv.y); w.y = pk_f16(xv.z, xv.w); ((GAS v2u*)(xb + (size_t)row * DM))[t] = w; }
    if (g_pre) {
        { const float w = wave_sum_dpp((xv.x * xv.x + xv.y * xv.y) + (xv.z * xv.z + xv.w * xv.w)); if (F.lane == 0) red[8 + F.wave] = w; }
        __syncthreads();
        float s2 = 0.f;
#pragma unroll
        for (int w = 0; w < 8; ++w) s2 += red[8 + w];
        const float rstd2 = __builtin_amdgcn_rsqf(s2 * (1.f / DM) + EPS);
        xv = xv * gpr * rstd2;
        if (Hq == nullptr) { v2u w; w.x = cvt_pk_bf16(xv.x, xv.y); w.y = cvt_pk_bf16(xv.z, xv.w); ((GAS v2u*)(H + (size_t)row * DM))[t] = w; }
        else {
            { const float w = wave_max_dpp(fmaxf(fmaxf(fabsf(xv.x), fabsf(xv.y)), fmaxf(fabsf(xv.z), fabsf(xv.w)))); if (F.lane == 0) red[16 + F.wave] = w; }
            __syncthreads();
            float am = 0.f;
#pragma unroll
            for (int w = 0; w < 8; ++w) am = fmaxf(am, red[16 + w]);
            const float inv = am > 0.f ? 127.f / am : 0.f;
            if (t == 0) rs[row] = am > 0.f ? am * (1.f / 127.f) : 1.f;
            const int q0 = (int)rintf(xv.x * inv), q1 = (int)rintf(xv.y * inv), q2 = (int)rintf(xv.z * inv), q3 = (int)rintf(xv.w * inv);
            ((GAS unsigned*)(Hq + (size_t)row * (DM / 4)))[t] = (unsigned)(q0 & 0xff) | ((unsigned)(q1 & 0xff) << 8) | ((unsigned)(q2 & 0xff) << 16) | ((unsigned)(q3 & 0xff) << 24);
        }
    }
    __syncthreads();
}
template <bool XOUT_F32, bool HAS_D = true>
__device__ __forceinline__ void resid_norm_fast(Frame& F, bf16* xb, float* xout, const bf16* Dm, float alpha, const float* g_post, const float* g_pre, bf16* H, unsigned* Hq, float* rs) {
    typedef float f32x2 __attribute__((ext_vector_type(2)));
    typedef _Float16 f16x2 __attribute__((ext_vector_type(2)));
    const int gw = F.vcu * NWAVES + F.wave, NGW = F.G * NWAVES, lane = F.lane;
    f32x2 gp[4][4], gn[4][4];
    if (HAS_D) {
#pragma unroll
    for (int j = 0; j < 4; ++j) { const f32x4 a = ((const GAS f32x4*)g_post)[2 * (lane + 64 * j)], b = ((const GAS f32x4*)g_post)[2 * (lane + 64 * j) + 1];
        gp[j][0] = (f32x2){a.x, a.y}; gp[j][1] = (f32x2){a.z, a.w}; gp[j][2] = (f32x2){b.x, b.y}; gp[j][3] = (f32x2){b.z, b.w}; } }
    const float* xin = (const float*)Dm;
    if (g_pre) {
#pragma unroll
        for (int j = 0; j < 4; ++j) { const f32x4 a = ((const GAS f32x4*)g_pre)[2 * (lane + 64 * j)], b = ((const GAS f32x4*)g_pre)[2 * (lane + 64 * j) + 1];
            gn[j][0] = (f32x2){a.x, a.y}; gn[j][1] = (f32x2){a.z, a.w}; gn[j][2] = (f32x2){b.x, b.y}; gn[j][3] = (f32x2){b.z, b.w}; } }
    v4u xr[4], dr[4];
    int row = gw;
    if (row < MP) {
#pragma unroll
        for (int j = 0; j < 4; ++j) { if (HAS_D) { xr[j] = ((const GAS v4u*)(xb + (size_t)row * DM))[lane + 64 * j]; dr[j] = ((const GAS v4u*)(Dm + (size_t)row * DM))[lane + 64 * j]; }
            else { xr[j] = ((const GAS v4u*)(xin + (size_t)row * DM))[2 * (lane + 64 * j)]; dr[j] = ((const GAS v4u*)(xin + (size_t)row * DM))[2 * (lane + 64 * j) + 1]; } } }
    for (; row < MP; row += NGW) {
        v4u xc[4], dc[4];
#pragma unroll
        for (int j = 0; j < 4; ++j) { xc[j] = xr[j]; dc[j] = dr[j]; }
        const int nrow = row + NGW;
        if (nrow < MP) {
#pragma unroll
            for (int j = 0; j < 4; ++j) { if (HAS_D) { xr[j] = ((const GAS v4u*)(xb + (size_t)nrow * DM))[lane + 64 * j]; dr[j] = ((const GAS v4u*)(Dm + (size_t)nrow * DM))[lane + 64 * j]; }
                else { xr[j] = ((const GAS v4u*)(xin + (size_t)nrow * DM))[2 * (lane + 64 * j)]; dr[j] = ((const GAS v4u*)(xin + (size_t)nrow * DM))[2 * (lane + 64 * j) + 1]; } } }
        f32x2 xv[4][4]; f32x2 ss2 = (f32x2){0.f, 0.f};
        if (HAS_D) {
        f32x2 dv[4][4]; f32x2 ssv = (f32x2){0.f, 0.f};
#pragma unroll
        for (int j = 0; j < 4; ++j)
#pragma unroll
            for (int e = 0; e < 4; ++e) { const unsigned w = dc[j][e]; dv[j][e] = (f32x2){__builtin_bit_cast(float, w << 16), __builtin_bit_cast(float, w & 0xffff0000u)}; ssv = dv[j][e] * dv[j][e] + ssv; }
        const float rstd = alpha * __builtin_amdgcn_rsqf(wave_sum_dpp(ssv.x + ssv.y) * (1.f / DM) + EPS);
#pragma unroll
        for (int j = 0; j < 4; ++j)
#pragma unroll
            for (int e = 0; e < 4; ++e) { const unsigned xw = xc[j][e]; const f16x2 hx = __builtin_bit_cast(f16x2, xw); const f32x2 x0 = (f32x2){(float)hx.x, (float)hx.y};
                xv[j][e] = (dv[j][e] * gp[j][e]) * rstd + x0; ss2 = xv[j][e] * xv[j][e] + ss2; }
        } else {
#pragma unroll
        for (int j = 0; j < 4; ++j) { const unsigned a0 = xc[j].x, a1 = xc[j].y, a2 = xc[j].z, a3 = xc[j].w, b0 = dc[j].x, b1 = dc[j].y, b2 = dc[j].z, b3 = dc[j].w;
            xv[j][0] = (f32x2){__builtin_bit_cast(float, a0), __builtin_bit_cast(float, a1)}; xv[j][1] = (f32x2){__builtin_bit_cast(float, a2), __builtin_bit_cast(float, a3)};
            xv[j][2] = (f32x2){__builtin_bit_cast(float, b0), __builtin_bit_cast(float, b1)}; xv[j][3] = (f32x2){__builtin_bit_cast(float, b2), __builtin_bit_cast(float, b3)};
#pragma unroll
            for (int e = 0; e < 4; ++e) ss2 = xv[j][e] * xv[j][e] + ss2; }
        }
        if (XOUT_F32) {
#pragma unroll
            for (int j = 0; j < 4; ++j) { ((GAS f32x4*)(xout + (size_t)row * DM))[2 * (lane + 64 * j)] = (f32x4){xv[j][0].x, xv[j][0].y, xv[j][1].x, xv[j][1].y};
                ((GAS f32x4*)(xout + (size_t)row * DM))[2 * (lane + 64 * j) + 1] = (f32x4){xv[j][2].x, xv[j][2].y, xv[j][3].x, xv[j][3].y}; }
        } else {
#pragma unroll
            for (int j = 0; j < 4; ++j) { v4u w;
#pragma unroll
                for (int e = 0; e < 4; ++e) w[e] = __builtin_bit_cast(unsigned, __builtin_convertvector(xv[j][e], f16x2));
                ((GAS v4u*)(xb + (size_t)row * DM))[lane + 64 * j] = w; } }
        if (g_pre) {
            const float rstd2 = __builtin_amdgcn_rsqf(wave_sum_dpp(ss2.x + ss2.y) * (1.f / DM) + EPS);
            if (Hq == nullptr) {
#pragma unroll
                for (int j = 0; j < 4; ++j) { v4u w;
#pragma unroll
                    for (int e = 0; e < 4; ++e) { const f32x2 o = (xv[j][e] * gn[j][e]) * rstd2; w[e] = cvt_pk_bf16(o.x, o.y); }
                    ((GAS v4u*)(H + (size_t)row * DM))[lane + 64 * j] = w; }
            } else {
                float am = 0.f;
#pragma unroll
                for (int j = 0; j < 4; ++j)
#pragma unroll
                    for (int e = 0; e < 4; ++e) { xv[j][e] = (xv[j][e] * gn[j][e]) * rstd2; am = fmaxf(am, fmaxf(fabsf(xv[j][e].x), fabsf(xv[j][e].y))); }
                am = wave_max_dpp(am); const float inv = am > 0.f ? 127.f / am : 0.f;
                if (lane == 0) rs[row] = am > 0.f ? am * (1.f / 127.f) : 1.f;
#pragma unroll
                for (int j = 0; j < 4; ++j) { unsigned wq[2];
#pragma unroll
                    for (int h = 0; h < 2; ++h) { const float xa = xv[j][2 * h].x, xb_ = xv[j][2 * h].y, xc_ = xv[j][2 * h + 1].x, xd = xv[j][2 * h + 1].y;
                        const float qa = fmaf(xa, inv, 12582912.f), qb = fmaf(xb_, inv, 12582912.f), qc = fmaf(xc_, inv, 12582912.f), qd = fmaf(xd, inv, 12582912.f);
                        unsigned w = __builtin_amdgcn_perm(__builtin_bit_cast(unsigned, qb), __builtin_bit_cast(unsigned, qa), 0x0c0c0400u);
                        w = __builtin_amdgcn_perm(__builtin_bit_cast(unsigned, qc), w, 0x0c040100u);
                        w = __builtin_amdgcn_perm(__builtin_bit_cast(unsigned, qd), w, 0x04020100u);
                        wq[h] = w; }
                    v2u w2; w2.x = wq[0]; w2.y = wq[1];
                    ((GAS v2u*)((GAS unsigned char*)Hq + (size_t)row * DM))[lane + 64 * j] = w2; }
            }
        }
    }
}

template <int NB, class RowB, class Epi>
__device__ __forceinline__ void skinny_gemm(Frame& F, const bf16* A, int lda, const bf16* Bt, int K, int nunits, int ufirst, int ustride, const RowB& rowb, const Epi& epi) {
    LAS float* red = (LAS float*)(F.lds + RING_OFF);
    const int r = F.lane & 31, h = F.lane >> 5, kper = K / 8, kbeg = F.wave * kper, nit = kper / 64;
    for (int u = ufirst; u < nunits; u += ustride) {
        f32x16 acc[NB];
#pragma unroll
        for (int b = 0; b < NB; ++b)
#pragma unroll
            for (int e = 0; e < 16; ++e) acc[b][e] = 0.f;
        const bf16* ap = A + (size_t)r * lda + kbeg + 32 * h;
        const bf16* bp[NB];
#pragma unroll
        for (int b = 0; b < NB; ++b) bp[b] = Bt + (size_t)(rowb(u, b) + r) * K + kbeg + 32 * h;
        bf16x8 a4[2][4], b4[2][NB][4];
#pragma unroll
        for (int i = 0; i < 4; ++i) a4[0][i] = *(const GAS bf16x8*)(ap + 8 * i);
#pragma unroll
        for (int b = 0; b < NB; ++b)
#pragma unroll
            for (int i = 0; i < 4; ++i) b4[0][b][i] = *(const GAS bf16x8*)(bp[b] + 8 * i);
        for (int it = 0; it < nit; it += 2) {
            { const int kk = (it + 1 < nit ? it + 1 : it) * 64;
#pragma unroll
              for (int i = 0; i < 4; ++i) a4[1][i] = *(const GAS bf16x8*)(ap + kk + 8 * i);
#pragma unroll
              for (int b = 0; b < NB; ++b)
#pragma unroll
                  for (int i = 0; i < 4; ++i) b4[1][b][i] = *(const GAS bf16x8*)(bp[b] + kk + 8 * i); }
#pragma unroll
            for (int b = 0; b < NB; ++b)
#pragma unroll
                for (int i = 0; i < 4; ++i) acc[b] = __builtin_amdgcn_mfma_f32_32x32x16_bf16(a4[0][i], b4[0][b][i], acc[b], 0, 0, 0);
            if (it + 1 < nit) {
                { const int kk = (it + 2 < nit ? it + 2 : it + 1) * 64;
#pragma unroll
                  for (int i = 0; i < 4; ++i) a4[0][i] = *(const GAS bf16x8*)(ap + kk + 8 * i);
#pragma unroll
                  for (int b = 0; b < NB; ++b)
#pragma unroll
                      for (int i = 0; i < 4; ++i) b4[0][b][i] = *(const GAS bf16x8*)(bp[b] + kk + 8 * i); }
#pragma unroll
                for (int b = 0; b < NB; ++b)
#pragma unroll
                    for (int i = 0; i < 4; ++i) acc[b] = __builtin_amdgcn_mfma_f32_32x32x16_bf16(a4[1][i], b4[1][b][i], acc[b], 0, 0, 0);
            }
        }
#pragma unroll
        for (int b = 0; b < NB; ++b)
#pragma unroll
            for (int e = 0; e < 16; ++e) red[((F.wave * NB + b) * 32 + ((e & 3) + 8 * (e >> 2) + 4 * h)) * 32 + r] = acc[b][e];
        __syncthreads();
#pragma unroll
        for (int q = 0; q < 2; ++q) { const int e = F.tid + 512 * q, row = e >> 5, col = e & 31; float v[NB];
#pragma unroll
            for (int b = 0; b < NB; ++b) { float s = 0.f;
#pragma unroll
                for (int w = 0; w < 8; ++w) s += red[((w * NB + b) * 32 + row) * 32 + col];
                v[b] = s; }
            epi(u, row, col, v); }
        __syncthreads();
    }
}

template <class Epi>
__device__ __forceinline__ void skinny_gemm_i8(Frame& F, const signed char* A, const float* rs, const signed char* Bq, const float* cs, int nunits, int ufirst, int ustride, const Epi& epi) {
    LAS int* red = (LAS int*)(F.lds + RING_OFF);
    const int r = F.lane & 31, h = F.lane >> 5, kbeg = F.wave * (DM / 8);
    for (int u = ufirst; u < nunits; u += ustride) {
        i32x16 acc[2];
#pragma unroll
        for (int b = 0; b < 2; ++b)
#pragma unroll
            for (int e = 0; e < 16; ++e) acc[b][e] = 0;
        const int rb0 = 256 * (u >> 2) + 32 * (u & 3);
        const signed char* ap = A + (size_t)r * DM + kbeg + 64 * h;
        const signed char* bp0 = Bq + (size_t)(rb0 + r) * DM + kbeg + 64 * h;
        const signed char* bp1 = bp0 + (size_t)128 * DM;
        i32x4 a4[2][4], b4[2][2][4];
#pragma unroll
        for (int ch = 0; ch < 2; ++ch)
#pragma unroll
            for (int i = 0; i < 4; ++i) { a4[ch][i] = *(const GAS i32x4*)(ap + 128 * ch + 16 * i); b4[ch][0][i] = *(const GAS i32x4*)(bp0 + 128 * ch + 16 * i); b4[ch][1][i] = *(const GAS i32x4*)(bp1 + 128 * ch + 16 * i); }
#pragma unroll
        for (int ch = 0; ch < 2; ++ch)
#pragma unroll
            for (int b = 0; b < 2; ++b)
#pragma unroll
                for (int i = 0; i < 4; ++i) acc[b] = __builtin_amdgcn_mfma_i32_32x32x32_i8(a4[ch][i], b4[ch][b][i], acc[b], 0, 0, 0);
#pragma unroll
        for (int b = 0; b < 2; ++b)
#pragma unroll
            for (int e = 0; e < 16; ++e) red[((F.wave * 2 + b) * 32 + ((e & 3) + 8 * (e >> 2) + 4 * h)) * 32 + r] = acc[b][e];
        __syncthreads();
#pragma unroll
        for (int q = 0; q < 2; ++q) { const int e = F.tid + 512 * q, row = e >> 5, col = e & 31; float v[2]; const float rsc = rs[row];
#pragma unroll
            for (int b = 0; b < 2; ++b) { int sm = 0;
#pragma unroll
                for (int w = 0; w < 8; ++w) sm += red[((w * 2 + b) * 32 + row) * 32 + col];
                v[b] = (float)sm * rsc * cs[rb0 + 128 * b + col]; }
            epi(u, row, col, v); }
        __syncthreads();
    }
}

template <int NB, class RowB, class ColMap>
__device__ __forceinline__ void skinny_ks(Frame& F, const bf16* A, int lda, const bf16* Bt, int K, int ncg, int nsl, const RowB& rowb, const ColMap& colmap, float* P, int ldp) {
    LAS float* red = (LAS float*)(F.lds + RING_OFF);
    const int fr = F.lane & 15, fq = F.lane >> 4, cps = (K / 64) / nsl;
    for (int u = F.vcu; u < ncg * nsl; u += F.G) { const int cg = u % ncg, sl = u / ncg;
        const int c0 = sl * cps + (cps * F.wave) / 8, c1 = sl * cps + (cps * (F.wave + 1)) / 8, nc = c1 - c0;
        f32x4 acc[NB][2][2];
#pragma unroll
        for (int b = 0; b < NB; ++b)
#pragma unroll
            for (int bi = 0; bi < 2; ++bi)
#pragma unroll
                for (int bj = 0; bj < 2; ++bj) acc[b][bi][bj] = (f32x4){0.f, 0.f, 0.f, 0.f};
        const bf16* ap = A + (size_t)fr * lda + 64 * c0 + 8 * fq;
        bf16x8 a4[3][2][2], b4[3][NB][2][2];
#pragma unroll
        for (int c = 0; c < 3; ++c) { if (c < nc) {
#pragma unroll
            for (int bi = 0; bi < 2; ++bi)
#pragma unroll
                for (int ks = 0; ks < 2; ++ks) a4[c][bi][ks] = *(const GAS bf16x8*)(ap + (size_t)(16 * bi) * lda + 64 * c + 32 * ks);
#pragma unroll
            for (int b = 0; b < NB; ++b) { const bf16* bp = Bt + (size_t)(rowb(cg, b) + fr) * K + 64 * c0 + 8 * fq;
#pragma unroll
                for (int bj = 0; bj < 2; ++bj)
#pragma unroll
                    for (int ks = 0; ks < 2; ++ks) b4[c][b][bj][ks] = *(const GAS bf16x8*)(bp + (size_t)(16 * bj) * K + 64 * c + 32 * ks); } } }
#pragma unroll
        for (int c = 0; c < 3; ++c) { if (c < nc) {
#pragma unroll
            for (int b = 0; b < NB; ++b)
#pragma unroll
                for (int ks = 0; ks < 2; ++ks)
#pragma unroll
                    for (int bi = 0; bi < 2; ++bi)
#pragma unroll
                        for (int bj = 0; bj < 2; ++bj) acc[b][bi][bj] = __builtin_amdgcn_mfma_f32_16x16x32_bf16(a4[c][bi][ks], b4[c][b][bj][ks], acc[b][bi][bj], 0, 0, 0); } }
#pragma unroll
        for (int b = 0; b < NB; ++b)
#pragma unroll
            for (int bi = 0; bi < 2; ++bi)
#pragma unroll
                for (int bj = 0; bj < 2; ++bj)
#pragma unroll
                    for (int e = 0; e < 4; ++e) red[((F.wave * NB + b) * 32 + (16 * bi + 4 * fq + e)) * 32 + 16 * bj + fr] = acc[b][bi][bj][e];
        __syncthreads();
#pragma unroll
        for (int q = 0; q < 2; ++q) { const int e = F.tid + 512 * q, row = e >> 5, col = e & 31;
#pragma unroll
            for (int b = 0; b < NB; ++b) { float sm = 0.f;
#pragma unroll
                for (int w = 0; w < 8; ++w) sm += red[((w * NB + b) * 32 + row) * 32 + col];
                P[((size_t)sl * MS + row) * ldp + colmap(cg, b) + col] = sm; } }
        __syncthreads();
    }
}

constexpr int KS_STRIDE = 72, VT_STRIDE = 260;
constexpr int ATT_KS_OFF = 0, ATT_VT_OFF = 256 * KS_STRIDE * 2;
constexpr float LOG2E = 1.4426950408889634f;

__device__ __forceinline__ void unpack8(const v4u w, float (&o)[8]) { const unsigned ww[4] = {w.x, w.y, w.z, w.w};
#pragma unroll
    for (int e = 0; e < 4; ++e) { o[2 * e] = bf2f((bf16)(ww[e] & 0xffffu)); o[2 * e + 1] = bf2f((bf16)(ww[e] >> 16)); } }
__device__ __forceinline__ void attn_prompt_unit(Frame& F, int b, int kvh, int blk, const bf16* Q, const bf16* Kb, const bf16* Vb, bf16* O, const float* sinks) {
    LAS bf16* Ks = (LAS bf16*)(F.lds + RING_OFF + ATT_KS_OFF);
    LAS bf16* Vt = (LAS bf16*)(F.lds + RING_OFF + ATT_VT_OFF);
    const int lane = F.lane, r = lane & 31, h = lane >> 5;
    const int head = kvh * 8 + F.wave;
    bf16x8 qfa[4][4];
#pragma unroll
    for (int a = 0; a < 4; ++a)
#pragma unroll
        for (int c = 0; c < 4; ++c) qfa[a][c] = *(const GAS bf16x8*)(Q + (size_t)(b * SEQ + blk * 128 + 32 * a + r) * DM + head * 64 + 16 * c + 8 * h);
    const int kpos0 = blk * 128 - 128;
#pragma unroll
    for (int i = 0; i < 4; ++i) { const int idx = F.tid + 512 * i, s = idx >> 3, c = idx & 7; const int kp = kpos0 + s;
        v4u kv = (v4u){0u, 0u, 0u, 0u}, vv = (v4u){0u, 0u, 0u, 0u};
        if (kp >= 0) { const size_t off = (size_t)(b * SEQ + kp) * 256 + kvh * 64 + 8 * c; kv = *(const GAS v4u*)(Kb + off); vv = *(const GAS v4u*)(Vb + off); }
        *(LAS v4u*)(Ks + s * KS_STRIDE + 8 * c) = kv;
        const unsigned w[4] = {vv.x, vv.y, vv.z, vv.w};
#pragma unroll
        for (int e = 0; e < 4; ++e) { Vt[(8 * c + 2 * e) * VT_STRIDE + s] = (bf16)(w[e] & 0xffffu); Vt[(8 * c + 2 * e + 1) * VT_STRIDE + s] = (bf16)(w[e] >> 16); } }
    __syncthreads();
    const float sink2 = sinks[head] * LOG2E;
    const float sc2 = ATTN_SCALE * LOG2E;
#pragma unroll
    for (int a = 0; a < 4; ++a) {
        const int qrow = b * SEQ + blk * 128 + 32 * a + r;
        bf16x8 qf[4];
#pragma unroll
        for (int c = 0; c < 4; ++c) qf[c] = qfa[a][c];
        f32x16 st[5];
#pragma unroll
        for (int j = 0; j < 5; ++j) {
#pragma unroll
            for (int e = 0; e < 16; ++e) st[j][e] = 0.f;
#pragma unroll
            for (int c = 0; c < 4; ++c) { const bf16x8 kf = *(const LAS bf16x8*)(Ks + (32 * (a + j) + r) * KS_STRIDE + 16 * c + 8 * h);
                st[j] = __builtin_amdgcn_mfma_f32_32x32x16_bf16(kf, qf[c], st[j], 0, 0, 0); } }
        float mx = -3.0e38f;
#pragma unroll
        for (int j = 0; j < 5; ++j) { const bool tile_ok = (blk > 0) || (a + j >= 4);
#pragma unroll
            for (int e = 0; e < 16; ++e) { const int kr = (e & 3) + 8 * (e >> 2) + 4 * h;
                float t = st[j][e];
                if (j == 0) t = (kr > r) ? t : -3.0e38f;
                if (j == 4) t = (kr <= r) ? t : -3.0e38f;
                if (!tile_ok) t = -3.0e38f;
                st[j][e] = t; mx = fmaxf(mx, t); } }
        mx = fmaxf(mx, __shfl_xor(mx, 32)); mx = fmaxf(mx * sc2, sink2);
        float sum = 0.f;
#pragma unroll
        for (int j = 0; j < 5; ++j)
#pragma unroll
            for (int e = 0; e < 16; ++e) { const float p = __builtin_amdgcn_exp2f(fmaf(st[j][e], sc2, -mx)); st[j][e] = p; sum += p; }
        sum += __shfl_xor(sum, 32); sum += __builtin_amdgcn_exp2f(sink2 - mx);
        const float inv = 1.0f / sum;
        f32x16 o[2];
#pragma unroll
        for (int d = 0; d < 2; ++d)
#pragma unroll
            for (int e = 0; e < 16; ++e) o[d][e] = 0.f;
#pragma unroll
        for (int j = 0; j < 5; ++j)
#pragma unroll
            for (int ks = 0; ks < 2; ++ks) {
                bf16x8 pf; { v4u w; w.x = cvt_pk_bf16(st[j][8 * ks + 0], st[j][8 * ks + 1]); w.y = cvt_pk_bf16(st[j][8 * ks + 2], st[j][8 * ks + 3]); w.z = cvt_pk_bf16(st[j][8 * ks + 4], st[j][8 * ks + 5]); w.w = cvt_pk_bf16(st[j][8 * ks + 6], st[j][8 * ks + 7]); pf = __builtin_bit_cast(bf16x8, w); }
#pragma unroll
                for (int d = 0; d < 2; ++d) { const LAS bf16* vp = Vt + (32 * d + r) * VT_STRIDE + 32 * (a + j) + 16 * ks + 4 * h;
                    const v2u lo = *(const LAS v2u*)vp, hi = *(const LAS v2u*)(vp + 8);
                    const v4u vw = (v4u){lo.x, lo.y, hi.x, hi.y};
                    o[d] = __builtin_amdgcn_mfma_f32_32x32x16_bf16(__builtin_bit_cast(bf16x8, vw), pf, o[d], 0, 0, 0); } }
#pragma unroll
        for (int d = 0; d < 2; ++d)
#pragma unroll
            for (int g = 0; g < 4; ++g) { v2u w; w.x = cvt_pk_bf16(o[d][4 * g] * inv, o[d][4 * g + 1] * inv); w.y = cvt_pk_bf16(o[d][4 * g + 2] * inv, o[d][4 * g + 3] * inv);
                *(GAS v2u*)(O + (size_t)qrow * DM + head * 64 + 32 * d + 8 * g + 4 * h) = w; }
    }
    __syncthreads();
}

constexpr int SK_STRIDE = 65;
constexpr int ATS_K_OFF = 0, ATS_V_OFF = 128 * SK_STRIDE * 4, ATS_Q_OFF = ATS_V_OFF + 128 * 64 * 4, ATS_P_OFF = ATS_Q_OFF + 8 * 64 * 4, ATS_END = ATS_P_OFF + 8 * 128 * 4;
static_assert(ATS_END <= RING_BYTES, "sample attention LDS");
__device__ __forceinline__ void attn_sample_unit(Frame& F, int b, int kvh, const bf16* Q, const bf16* Kb, const bf16* Vb, bf16* O, const float* sinks, const float* cache_k, const float* cache_v, float* outk, float* outv) {
    LAS float* Kc = (LAS float*)(F.lds + RING_OFF + ATS_K_OFF);
    LAS float* Vc = (LAS float*)(F.lds + RING_OFF + ATS_V_OFF);
    LAS float* qs = (LAS float*)(F.lds + RING_OFF + ATS_Q_OFF) + F.wave * 64;
    LAS float* ps = (LAS float*)(F.lds + RING_OFF + ATS_P_OFF) + F.wave * 128;
    const int lane = F.lane, head = kvh * 8 + F.wave;
    const size_t qrow = (size_t)(MP + b);
    f32x4 kr[4], vr[4];
#pragma unroll
    for (int i = 0; i < 4; ++i) { const int idx = F.tid + 512 * i, j = idx >> 4, c = idx & 15;
        if (j < 127) { const size_t ii = ((size_t)(b * 128 + j + 1) * NKV + kvh) * 64 + 4 * c; kr[i] = *(const GAS f32x4*)(cache_k + ii); vr[i] = *(const GAS f32x4*)(cache_v + ii); }
        else { const v2u kw = *(const GAS v2u*)(Kb + qrow * 256 + kvh * 64 + 4 * c), vw = *(const GAS v2u*)(Vb + qrow * 256 + kvh * 64 + 4 * c);
            kr[i] = (f32x4){bf2f((bf16)(kw.x & 0xffffu)), bf2f((bf16)(kw.x >> 16)), bf2f((bf16)(kw.y & 0xffffu)), bf2f((bf16)(kw.y >> 16))};
            vr[i] = (f32x4){bf2f((bf16)(vw.x & 0xffffu)), bf2f((bf16)(vw.x >> 16)), bf2f((bf16)(vw.y & 0xffffu)), bf2f((bf16)(vw.y >> 16))}; } }
    qs[lane] = bf2f(Q[qrow * DM + head * 64 + lane]);
#pragma unroll
    for (int i = 0; i < 4; ++i) { const int idx = F.tid + 512 * i, j = idx >> 4, c = idx & 15;
        LAS float* kd = Kc + j * SK_STRIDE + 4 * c; kd[0] = kr[i].x; kd[1] = kr[i].y; kd[2] = kr[i].z; kd[3] = kr[i].w;
        *(LAS f32x4*)(Vc + j * 64 + 4 * c) = vr[i];
        const size_t oo = ((size_t)(b * 128 + j) * NKV + kvh) * 64 + 4 * c;
        *(GAS f32x4*)(outk + oo) = kr[i]; *(GAS f32x4*)(outv + oo) = vr[i]; }
    __syncthreads();
    float sc[2];
#pragma unroll
    for (int t = 0; t < 2; ++t) { const LAS float* kp = Kc + (lane + 64 * t) * SK_STRIDE; float s0 = 0.f, s1 = 0.f;
#pragma unroll
        for (int d = 0; d < 64; d += 2) { s0 += kp[d] * qs[d]; s1 += kp[d + 1] * qs[d + 1]; }
        sc[t] = (s0 + s1) * ATTN_SCALE; }
    const float sink = sinks[head];
    const float mx = fmaxf(wave_max(fmaxf(sc[0], sc[1])), sink);
    const float p0 = __expf(sc[0] - mx), p1 = __expf(sc[1] - mx);
    const float den = wave_sum(p0 + p1) + __expf(sink - mx);
    ps[lane] = p0; ps[lane + 64] = p1;
    LDS_WAIT(); asm volatile("" ::: "memory");
    float o0 = 0.f, o1 = 0.f;
#pragma unroll 16
    for (int j = 0; j < 128; j += 2) { o0 += ps[j] * Vc[j * 64 + lane]; o1 += ps[j + 1] * Vc[(j + 1) * 64 + lane]; }
    O[qrow * DM + head * 64 + lane] = f2bf((o0 + o1) / den);
    LDS_WAIT(); asm volatile("" ::: "memory");
}

__device__ __forceinline__ void attn_phase_all(Frame& F, const In& in, const bf16* Q, const bf16* Kb, const bf16* Vb, bf16* O) {
    const float* sinks = in.p[12];
    for (int u = F.vcu; u < NB_P * NKV * 32; u += F.G) { const int b = u >> 7, kvh = (u >> 5) & 3, blk = u & 31;
        attn_prompt_unit(F, b, kvh, blk, Q, Kb, Vb, O, sinks);
        if (blk == 31) {
            v4u kq[2], vq[2];
#pragma unroll
            for (int it = 0; it < 2; ++it) { const int gi = F.tid + 512 * it, s = gi >> 3, c = gi & 7; const size_t src = (size_t)(b * SEQ + SEQ - 128 + s) * 256 + kvh * 64 + 8 * c;
                kq[it] = *(const GAS v4u*)(Kb + src); vq[it] = *(const GAS v4u*)(Vb + src); }
#pragma unroll
            for (int it = 0; it < 2; ++it) { const int gi = F.tid + 512 * it, s = gi >> 3, c = gi & 7; const size_t dst = ((size_t)(b * 128 + s) * NKV + kvh) * 64 + 8 * c;
                float kf[8], vf[8]; unpack8(kq[it], kf); unpack8(vq[it], vf);
                *(GAS f32x4*)(F.out + O_KP + dst) = (f32x4){kf[0], kf[1], kf[2], kf[3]}; *(GAS f32x4*)(F.out + O_KP + dst + 4) = (f32x4){kf[4], kf[5], kf[6], kf[7]};
                *(GAS f32x4*)(F.out + O_VP + dst) = (f32x4){vf[0], vf[1], vf[2], vf[3]}; *(GAS f32x4*)(F.out + O_VP + dst + 4) = (f32x4){vf[4], vf[5], vf[6], vf[7]}; } } }
    for (int u = F.vcu; u < MS * NKV; u += F.G) { __syncthreads(); attn_sample_unit(F, u >> 2, u & 3, Q, Kb, Vb, O, sinks, in.p[2], in.p[3], F.out + O_KS, F.out + O_VS); }
}

__device__ __forceinline__ void conv_pass(Frame& F, const In& in, const bf16* Y, const bf16* BG, bf16* A2, const float* PS, int nsl) {
    const int gw = F.vcu * NWAVES + F.wave, NGW = F.G * NWAVES;
    const float* cw = in.p[14];
    const float* st = in.p[4];
    f32x4 cwr[3][4][2];
#pragma unroll
    for (int k = 0; k < 3; ++k)
#pragma unroll
        for (int j = 0; j < 4; ++j)
#pragma unroll
            for (int hh = 0; hh < 2; ++hh) cwr[k][j][hh] = *(const GAS f32x4*)(cw + (size_t)k * DM + 8 * (F.lane + 64 * j) + 4 * hh);
    for (int row = gw; row < MP; row += NGW) {
        v4u ry2[4], rbg[4], ry1[4], ry0[4];
        const int t = row & (SEQ - 1);
#pragma unroll
        for (int j = 0; j < 4; ++j) { const int c0 = 8 * (F.lane + 64 * j); const v4u z = (v4u){0u, 0u, 0u, 0u};
            ry2[j] = *(const GAS v4u*)(Y + (size_t)row * DM + c0); rbg[j] = *(const GAS v4u*)(BG + (size_t)row * DM + c0);
            ry1[j] = (t >= 1) ? *(const GAS v4u*)(Y + (size_t)(row - 1) * DM + c0) : z; ry0[j] = (t >= 2) ? *(const GAS v4u*)(Y + (size_t)(row - 2) * DM + c0) : z; }
#pragma unroll
        for (int j = 0; j < 4; ++j) { const int c0 = 8 * (F.lane + 64 * j);
            float y0[8], y1[8], y2[8], bg[8];
            unpack8(ry2[j], y2); unpack8(rbg[j], bg); unpack8(ry1[j], y1); unpack8(ry0[j], y0);
            if (t >= SEQ - 2) { float* o = F.out + O_CP + ((size_t)(row >> 12) * 2 + (t - (SEQ - 2))) * DM + c0;
#pragma unroll
                for (int e = 0; e < 8; ++e) o[e] = y2[e]; }
            float r[8];
#pragma unroll
            for (int hh = 0; hh < 2; ++hh) { const f32x4 a = cwr[0][j][hh], b = cwr[1][j][hh], d = cwr[2][j][hh];
                r[4 * hh + 0] = bg[4 * hh + 0] * (a.x * y0[4 * hh + 0] + b.x * y1[4 * hh + 0] + d.x * y2[4 * hh + 0]);
                r[4 * hh + 1] = bg[4 * hh + 1] * (a.y * y0[4 * hh + 1] + b.y * y1[4 * hh + 1] + d.y * y2[4 * hh + 1]);
                r[4 * hh + 2] = bg[4 * hh + 2] * (a.z * y0[4 * hh + 2] + b.z * y1[4 * hh + 2] + d.z * y2[4 * hh + 2]);
                r[4 * hh + 3] = bg[4 * hh + 3] * (a.w * y0[4 * hh + 3] + b.w * y1[4 * hh + 3] + d.w * y2[4 * hh + 3]); }
            v4u w; w.x = cvt_pk_bf16(r[0], r[1]); w.y = cvt_pk_bf16(r[2], r[3]); w.z = cvt_pk_bf16(r[4], r[5]); w.w = cvt_pk_bf16(r[6], r[7]);
            *(GAS v4u*)(A2 + (size_t)row * DM + c0) = w; }
    }
    { const bool spread = (NGW % MS == 0); const int b = spread ? ((gw % (NGW / MS) == 0) ? gw / (NGW / MS) : MS) : gw;
      if (b < MS) { const int row = MP + b;
#pragma unroll
        for (int j = 0; j < 4; ++j) { const int c0 = 8 * (F.lane + 64 * j);
            f32x4 pv[4][3][2]; f32x4 s0[2], s1[2];
#pragma unroll
            for (int sl = 0; sl < 4; ++sl)
#pragma unroll
                for (int k = 0; k < 3; ++k)
#pragma unroll
                    for (int hh = 0; hh < 2; ++hh) pv[sl][k][hh] = (sl < nsl) ? *(const GAS f32x4*)(PS + ((size_t)sl * MS + b) * (3 * DM) + (size_t)k * DM + c0 + 4 * hh) : (f32x4){0.f, 0.f, 0.f, 0.f};
#pragma unroll
            for (int hh = 0; hh < 2; ++hh) { s0[hh] = *(const GAS f32x4*)(st + ((size_t)b * 2 + 0) * DM + c0 + 4 * hh); s1[hh] = *(const GAS f32x4*)(st + ((size_t)b * 2 + 1) * DM + c0 + 4 * hh); }
            float* o = F.out + O_CS + (size_t)b * 2 * DM + c0; v4u w;
#pragma unroll
            for (int hh = 0; hh < 2; ++hh) { const f32x4 cg = (pv[0][0][hh] + pv[1][0][hh]) + (pv[2][0][hh] + pv[3][0][hh]), hv = (pv[0][1][hh] + pv[1][1][hh]) + (pv[2][1][hh] + pv[3][1][hh]), bgv = (pv[0][2][hh] + pv[1][2][hh]) + (pv[2][2][hh] + pv[3][2][hh]);
                const f32x4 y2 = cg * hv, y1 = s1[hh], y0 = s0[hh];
                *(GAS f32x4*)(o + 4 * hh) = y1; *(GAS f32x4*)(o + DM + 4 * hh) = y2;
                const f32x4 r = bgv * (cwr[0][j][hh] * y0 + cwr[1][j][hh] * y1 + cwr[2][j][hh] * y2);
                w[2 * hh] = cvt_pk_bf16(r.x, r.y); w[2 * hh + 1] = cvt_pk_bf16(r.z, r.w); }
            *(GAS v4u*)(A2 + (size_t)row * DM + c0) = w; } } }
}

__device__ __forceinline__ void sincos_cw(float x, float& s, float& c) {
    const float kf = rintf(x * 0.63661977236758134f); const int k = (int)kf;
    float r = fmaf(-kf, 1.5707962513e+00f, x); r = fmaf(-kf, 7.5497894159e-08f, r); r = fmaf(-kf, 5.3903029534e-15f, r);
    const float r2 = r * r;
    const float sp = r + r * r2 * (-1.6666654611e-1f + r2 * (8.3321608736e-3f + r2 * (-1.9515295891e-4f)));
    const float cp = 1.0f - 0.5f * r2 + r2 * r2 * (4.166664568298827e-2f + r2 * (-1.388731625493765e-3f + r2 * 2.443315711809948e-5f));
    const int q = k & 3;
    s = (q == 0) ? sp : (q == 1) ? cp : (q == 2) ? -sp : -cp;
    c = (q == 0) ? cp : (q == 1) ? -sp : (q == 2) ? -cp : sp;
}
constexpr int S5_BU_STRIDE = 132, S5_H_STRIDE = 136;
constexpr int S5_BU_BYTES = 16 * S5_BU_STRIDE * 4, S5_H_BYTES = 16 * S5_H_STRIDE * 2, S5_WAVE_BYTES = S5_BU_BYTES + S5_H_BYTES;
constexpr int S5_PAR_OFF = 8 * S5_WAVE_BYTES;
constexpr int S5_AB = S5_PAR_OFF, S5_BB = S5_AB + 1024, S5_E = S5_BB + 8192, S5_DD = S5_E + 4096, S5_END = S5_DD + 64;
static_assert(S5_END <= RING_BYTES, "S5 LDS");

template <int XM>
__device__ __forceinline__ void s5_unit(Frame& F, const In& in, int b, int g, const bf16* H, bf16* Z) {
    LAS float* AB = (LAS float*)(F.lds + RING_OFF + S5_AB);
    LAS float* BB = (LAS float*)(F.lds + RING_OFF + S5_BB);
    LAS float* EE = (LAS float*)(F.lds + RING_OFF + S5_E);
    LAS float* DD = (LAS float*)(F.lds + RING_OFF + S5_DD);
    LAS float* Bu = (LAS float*)(F.lds + RING_OFF + F.wave * S5_WAVE_BYTES);
    LAS bf16* Hs = (LAS bf16*)(F.lds + RING_OFF + F.wave * S5_WAVE_BYTES + S5_BU_BYTES);
    const int lane = F.lane, tid = F.tid;
    const float* a_re = in.p[16]; const float* a_im = in.p[17]; const float* log_dt = in.p[18]; const float* b_re = in.p[19]; const float* b_im = in.p[20];
    const float* c_re = in.p[21]; const float* c_im = in.p[22]; const float* d_skip = in.p[23];
    const int j16 = lane & 15, q = lane >> 4;
    f32x4 craw[4][2];
#pragma unroll
    for (int ks = 0; ks < 4; ++ks) { const int p0 = 16 * ks + 4 * q; craw[ks][0] = *(const GAS f32x4*)(c_re + ((size_t)g * SSG + j16) * SSP + p0); craw[ks][1] = *(const GAS f32x4*)(c_im + ((size_t)g * SSG + j16) * SSP + p0); }
    const int se0 = 16 * b + 2 * F.wave;
    v4u suw = (v4u){0u, 0u, 0u, 0u};
    if (j16 < 2 && q < 2) suw = *(const GAS v4u*)(H + (size_t)(MP + se0 + j16) * DM + g * SSG + 8 * q);
    float sh0r[2], sh0i[2];
#pragma unroll
    for (int t = 0; t < 2; ++t) { const size_t si = ((size_t)(se0 + t) * SSN + g) * SSP + lane; sh0r[t] = in.p[5][si]; sh0i[t] = in.p[6][si]; }
    __syncthreads();
    const float dt = __expf(log_dt[g]);
    {
        const int p = tid & 63; const float lr = a_re[g * SSP + p], li = a_im[g * SSP + p];
        const float mag = __expf(lr * dt); float sn, cs; sincos_cw(li * dt, sn, cs);
        const float abr = mag * cs, abi = mag * sn, den = lr * lr + li * li;
        const float kr = ((abr - 1.0f) * lr + abi * li) / den, ki = (abi * lr - (abr - 1.0f) * li) / den;
        if (tid < 64) { float pr = abr, pi = abi;
#pragma unroll
            for (int i = 0; i < 9; ++i) { const float nr = pr * pr - pi * pi, ni = 2.f * pr * pi; pr = nr; pi = ni; }
            AB[4 * p] = abr; AB[4 * p + 1] = abi; AB[4 * p + 2] = pr; AB[4 * p + 3] = pi; }
#pragma unroll
        for (int cc = 0; cc < 2; ++cc) { const int c = 2 * (tid >> 6) + cc; const float br = b_re[((size_t)g * SSP + p) * SSG + c], bi = b_im[((size_t)g * SSP + p) * SSG + c];
            BB[p * 16 + c] = kr * br - ki * bi; BB[1024 + p * 16 + c] = kr * bi + ki * br; }
        if (tid < 16) DD[tid] = d_skip[g * SSG + tid];
    }
    __syncthreads();
    bf16x8 bfrag[8];
#pragma unroll
    for (int ct = 0; ct < 8; ++ct) { v4u w;
        { const int comp = 16 * ct + j16; const LAS f32x4* src = (const LAS f32x4*)(BB + (comp & 1) * 1024 + (comp >> 1) * 16 + 8 * (q & 1));
            const f32x4 s0 = src[0], s1 = src[1];
            w.x = cvt_pk_bf16(s0.x, s0.y); w.y = cvt_pk_bf16(s0.z, s0.w); w.z = cvt_pk_bf16(s1.x, s1.y); w.w = cvt_pk_bf16(s1.z, s1.w); }
        bfrag[ct] = __builtin_bit_cast(bf16x8, w); }
    bf16x8 dfrag;
    { const float dv = DD[j16]; const unsigned db = (unsigned)f2bf(dv); v4u w = (v4u){0u, 0u, 0u, 0u}; const int e = j16 - 8 * (q & 1);
      if (e >= 0 && e < 8) { const unsigned val = (e & 1) ? (db << 16) : db; if ((e >> 1) == 0) w.x = val; else if ((e >> 1) == 1) w.y = val; else if ((e >> 1) == 2) w.z = val; else w.w = val; }
      dfrag = __builtin_bit_cast(bf16x8, w); }
    bf16x8 cfrag[4];
#pragma unroll
    for (int ks = 0; ks < 4; ++ks) { const f32x4 sr = craw[ks][0], si = craw[ks][1];
        v4u w; w.x = cvt_pk_bf16(sr.x, -si.x); w.y = cvt_pk_bf16(sr.y, -si.y); w.z = cvt_pk_bf16(sr.z, -si.z); w.w = cvt_pk_bf16(sr.w, -si.w);
        cfrag[ks] = __builtin_bit_cast(bf16x8, w); }
    typedef float f32x2 __attribute__((ext_vector_type(2)));
    const float ar = AB[4 * lane], ai = AB[4 * lane + 1];
    const f32x2 aa1 = (f32x2){ar, ar}, aa2 = (f32x2){-ai, ai};
    const size_t rowbase = (size_t)b * SEQ + (size_t)F.wave * 512;
    {   const int e0 = se0;
        const bf16x8 ufrag = __builtin_bit_cast(bf16x8, suw);
#pragma unroll
        for (int ct = 0; ct < 8; ++ct) { f32x4 acc = (f32x4){0.f, 0.f, 0.f, 0.f};
            acc = __builtin_amdgcn_mfma_f32_16x16x32_bf16(bfrag[ct], ufrag, acc, 0, 0, 0);
            *(LAS f32x4*)(Bu + j16 * S5_BU_STRIDE + 16 * ct + 4 * q) = acc; }
        LDS_WAIT(); asm volatile("" ::: "memory");
#pragma unroll
        for (int t = 0; t < 2; ++t) { const f32x2 bb = *(const LAS f32x2*)(Bu + t * S5_BU_STRIDE + 2 * lane);
            const size_t si = ((size_t)(e0 + t) * SSN + g) * SSP + lane;
            const float h0r = sh0r[t], h0i = sh0i[t];
            const float h1r = ar * h0r - ai * h0i + bb.x, h1i = ar * h0i + ai * h0r + bb.y;
            F.out[O_SRS + si] = h1r; F.out[O_SIS + si] = h1i;
            *(LAS unsigned*)(Hs + t * S5_H_STRIDE + 2 * lane) = cvt_pk_bf16(h1r, h1i); }
        LDS_WAIT(); asm volatile("" ::: "memory");
        f32x4 y = (f32x4){0.f, 0.f, 0.f, 0.f};
        y = __builtin_amdgcn_mfma_f32_16x16x32_bf16(dfrag, ufrag, y, 0, 0, 0);
#pragma unroll
        for (int ks = 0; ks < 4; ++ks) { const bf16x8 hf = *(const LAS bf16x8*)(Hs + j16 * S5_H_STRIDE + 32 * ks + 8 * q);
            y = __builtin_amdgcn_mfma_f32_16x16x32_bf16(cfrag[ks], hf, y, 0, 0, 0); }
        if (j16 < 2) {
            const float z0 = gelu_tanh_f(y[0]), z1 = gelu_tanh_f(y[1]), z2 = gelu_tanh_f(y[2]), z3 = gelu_tanh_f(y[3]);
            v2u zw; zw.x = cvt_pk_bf16(z0, z1); zw.y = cvt_pk_bf16(z2, z3);
            *(GAS v2u*)(Z + (size_t)(MP + e0 + j16) * DM + g * SSG + 4 * q) = zw; }
        LDS_WAIT(); asm volatile("" ::: "memory");
    }
    f32x2 hh = (f32x2){0.f, 0.f};
    for (int pass = 0; pass < (XM == 2 ? 1 : XM == 3 ? 0 : 2); ++pass) {
        if (pass == 1) {
            EE[F.wave * 128 + lane] = hh.x; EE[F.wave * 128 + 64 + lane] = hh.y;
            __syncthreads();
            const float a5r = AB[4 * lane + 2], a5i = AB[4 * lane + 3];
            float cr = 0.f, ci = 0.f;
            for (int w = 0; w < F.wave; ++w) { const float er = EE[w * 128 + lane], ei = EE[w * 128 + 64 + lane]; const float nr = a5r * cr - a5i * ci + er, ni = a5r * ci + a5i * cr + ei; cr = nr; ci = ni; }
            hh = (f32x2){cr, ci};
        }
        constexpr int PF = 8;
        v4u uring[PF];
        const bf16* ubase = H + (rowbase + 16 * (q >> 1) + j16) * DM + g * SSG + 8 * (q & 1);
#pragma unroll
        for (int k = 0; k < PF; ++k) uring[k] = *(const GAS v4u*)(ubase + (size_t)(32 * k) * DM);
        for (int dc0 = 0; dc0 < 16; dc0 += PF) {
#pragma unroll
        for (int k = 0; k < PF; ++k) {
            const int dc = dc0 + k;
            const v4u upair = uring[k];
            if (dc + PF < 16) uring[k] = *(const GAS v4u*)(ubase + (size_t)(32 * (dc + PF)) * DM);
#pragma unroll
        for (int half = 0; half < 2; ++half) {
            const int ch = 2 * dc + half;
            const size_t row0 = rowbase + 16 * ch;
            const bool mine = (q >> 1) == half;
            v4u uw; uw.x = mine ? upair.x : 0u; uw.y = mine ? upair.y : 0u; uw.z = mine ? upair.z : 0u; uw.w = mine ? upair.w : 0u;
            const bf16x8 ufrag = __builtin_bit_cast(bf16x8, uw);
            {   f32x4 acc8[8];
#pragma unroll
                for (int ct = 0; ct < 8; ++ct) acc8[ct] = __builtin_amdgcn_mfma_f32_16x16x32_bf16(bfrag[ct], ufrag, (f32x4){0.f, 0.f, 0.f, 0.f}, 0, 0, 0);
#pragma unroll
                for (int ct = 0; ct < 8; ++ct) *(LAS f32x4*)(Bu + j16 * S5_BU_STRIDE + 16 * ct + 4 * q) = acc8[ct]; }
            LDS_WAIT(); asm volatile("" ::: "memory");
            f32x2 bbv[16];
#pragma unroll
            for (int t = 0; t < 16; ++t) bbv[t] = *(const LAS f32x2*)(Bu + t * S5_BU_STRIDE + 2 * lane);
            LDS_WAIT(); asm volatile("" ::: "memory");
            if (pass == 0) {
#pragma unroll
                for (int t = 0; t < 16; ++t) { const f32x2 hsw = (f32x2){hh.y, hh.x}; hh = aa1 * hh + (aa2 * hsw + bbv[t]); }
            } else {
                unsigned hp[16];
#pragma unroll
                for (int t = 0; t < 16; ++t) { const f32x2 hsw = (f32x2){hh.y, hh.x}; hh = aa1 * hh + (aa2 * hsw + bbv[t]); hp[t] = cvt_pk_bf16(hh.x, hh.y); }
#pragma unroll
                for (int t = 0; t < 16; ++t) *(LAS unsigned*)(Hs + t * S5_H_STRIDE + 2 * lane) = hp[t];
                LDS_WAIT(); asm volatile("" ::: "memory");
                bf16x8 hf[4];
#pragma unroll
                for (int ks = 0; ks < 4; ++ks) hf[ks] = *(const LAS bf16x8*)(Hs + j16 * S5_H_STRIDE + 32 * ks + 8 * q);
                f32x4 y = __builtin_amdgcn_mfma_f32_16x16x32_bf16(dfrag, ufrag, (f32x4){0.f, 0.f, 0.f, 0.f}, 0, 0, 0);
                f32x4 y2 = __builtin_amdgcn_mfma_f32_16x16x32_bf16(cfrag[0], hf[0], (f32x4){0.f, 0.f, 0.f, 0.f}, 0, 0, 0);
                y = __builtin_amdgcn_mfma_f32_16x16x32_bf16(cfrag[1], hf[1], y, 0, 0, 0);
                y2 = __builtin_amdgcn_mfma_f32_16x16x32_bf16(cfrag[2], hf[2], y2, 0, 0, 0);
                y = __builtin_amdgcn_mfma_f32_16x16x32_bf16(cfrag[3], hf[3], y, 0, 0, 0);
                y = y + y2;
                const f32x2_t za = gelu_tanh_pk((f32x2_t){y.x, y.y}), zb = gelu_tanh_pk((f32x2_t){y.z, y.w});
                v2u zw; zw.x = cvt_pk_bf16(za.x, za.y); zw.y = cvt_pk_bf16(zb.x, zb.y);
                if (XM != 1) *(GAS v2u*)(Z + (row0 + j16) * DM + g * SSG + 4 * q) = zw; else if (zw.x == 0x12345678u && zw.y == 0x9abcdef0u) *(GAS v2u*)(Z + (row0 + j16) * DM + g * SSG + 4 * q) = zw;
            }
            LDS_WAIT(); asm volatile("" ::: "memory");
        }
        }
        }
    }
    if (XM < 2 && F.wave == 7) { F.out[O_SRP + ((size_t)b * SSN + g) * SSP + lane] = hh.x; F.out[O_SIP + ((size_t)b * SSN + g) * SSP + lane] = hh.y; }

}
#ifndef S5_XMODE
#define S5_XMODE 0
#endif
template <int XM = 0>
__device__ __forceinline__ void s5_phase(Frame& F, const In& in, const bf16* H, bf16* Z) {
    for (int u = F.vcu; u < NB_P * SSN; u += F.G) s5_unit<XM>(F, in, u >> 7, u & 127, H, Z);
    __syncthreads();
}

__device__ __forceinline__ void gm_ln_pass(Frame& F, const In& in, const bf16* U, const bf16* V, bf16* VN, bf16* A3, const float* PS, int nsl) {
    const int gw = F.vcu * NWAVES + F.wave, NGW = F.G * NWAVES;
    const float* lg = in.p[27]; const float* lb = in.p[28]; const float* w_s = in.p[29]; const float* b_s = in.p[30];
    float lgv[4][8], lbv[4][8];
#pragma unroll
    for (int j = 0; j < 4; ++j)
#pragma unroll
        for (int hh = 0; hh < 2; ++hh) { const int c = 8 * (F.lane + 64 * j) + 4 * hh; const f32x4 a = *(const GAS f32x4*)(lg + c), b = *(const GAS f32x4*)(lb + c);
            lgv[j][4 * hh] = a.x; lgv[j][4 * hh + 1] = a.y; lgv[j][4 * hh + 2] = a.z; lgv[j][4 * hh + 3] = a.w; lbv[j][4 * hh] = b.x; lbv[j][4 * hh + 1] = b.y; lbv[j][4 * hh + 2] = b.z; lbv[j][4 * hh + 3] = b.w; }
    {
        v4u nx[4]; int prow = gw;
        if (prow < MP) {
#pragma unroll
            for (int j = 0; j < 4; ++j) nx[j] = *(const GAS v4u*)(V + (size_t)prow * DM + 8 * (F.lane + 64 * j)); }
        for (; prow < MP; prow += NGW) {
            v4u cur[4];
#pragma unroll
            for (int j = 0; j < 4; ++j) cur[j] = nx[j];
            const int nrow = prow + NGW;
            if (nrow < MP) {
#pragma unroll
                for (int j = 0; j < 4; ++j) nx[j] = *(const GAS v4u*)(V + (size_t)nrow * DM + 8 * (F.lane + 64 * j)); }
            float v[4][8]; float s = 0.f;
#pragma unroll
            for (int j = 0; j < 4; ++j) { const unsigned ww[4] = {cur[j].x, cur[j].y, cur[j].z, cur[j].w};
#pragma unroll
                for (int e = 0; e < 4; ++e) { v[j][2 * e] = bf2f((bf16)(ww[e] & 0xffffu)); v[j][2 * e + 1] = bf2f((bf16)(ww[e] >> 16)); s += v[j][2 * e] + v[j][2 * e + 1]; } }
            const float mu = wave_sum_dpp(s) * (1.f / DM); float q = 0.f;
#pragma unroll
            for (int j = 0; j < 4; ++j)
#pragma unroll
                for (int e = 0; e < 8; ++e) { v[j][e] -= mu; q += v[j][e] * v[j][e]; }
            const float rstd = __builtin_amdgcn_rsqf(wave_sum_dpp(q) * (1.f / DM) + EPS);
#pragma unroll
            for (int j = 0; j < 4; ++j) { const int c0 = 8 * (F.lane + 64 * j); float o[8];
#pragma unroll
                for (int e = 0; e < 8; ++e) o[e] = v[j][e] * rstd * lgv[j][e] + lbv[j][e];
                v4u w; w.x = cvt_pk_bf16(o[0], o[1]); w.y = cvt_pk_bf16(o[2], o[3]); w.z = cvt_pk_bf16(o[4], o[5]); w.w = cvt_pk_bf16(o[6], o[7]); *(GAS v4u*)(VN + (size_t)prow * DM + c0) = w; }
        }
    }
    { const bool spread = (NGW % MS == 0); const int b = spread ? ((gw % (NGW / MS) == 0) ? gw / (NGW / MS) : MS) : gw;
      if (b < MS) { const int row = MP + b;
        f32x4 pu[2][4][2], pv[2][4][2]; float wv[4], bv[4];
#pragma unroll
        for (int sl = 0; sl < 2; ++sl)
#pragma unroll
            for (int j = 0; j < 4; ++j)
#pragma unroll
                for (int hh = 0; hh < 2; ++hh) { const float* pp = PS + ((size_t)sl * MS + b) * (2 * DM) + 8 * (F.lane + 64 * j) + 4 * hh; const f32x4 z = (f32x4){0.f, 0.f, 0.f, 0.f};
                    pu[sl][j][hh] = (sl < nsl) ? *(const GAS f32x4*)pp : z; pv[sl][j][hh] = (sl < nsl) ? *(const GAS f32x4*)(pp + DM) : z; }
#pragma unroll
        for (int j = 0; j < 4; ++j) { const int g = (8 * (F.lane + 64 * j)) >> 7; wv[j] = w_s[(size_t)g * GMC * GMC]; bv[j] = b_s[g * GMC]; }
        float v[4][8]; float s = 0.f;
#pragma unroll
        for (int j = 0; j < 4; ++j)
#pragma unroll
            for (int hh = 0; hh < 2; ++hh) { const f32x4 t = pv[0][j][hh] + pv[1][j][hh];
                v[j][4 * hh] = gelu_tanh_f(t.x); v[j][4 * hh + 1] = gelu_tanh_f(t.y); v[j][4 * hh + 2] = gelu_tanh_f(t.z); v[j][4 * hh + 3] = gelu_tanh_f(t.w);
                s += (v[j][4 * hh] + v[j][4 * hh + 1]) + (v[j][4 * hh + 2] + v[j][4 * hh + 3]); }
        const float mu = wave_sum(s) * (1.f / DM); float q = 0.f;
#pragma unroll
        for (int j = 0; j < 4; ++j)
#pragma unroll
            for (int e = 0; e < 8; ++e) { v[j][e] -= mu; q += v[j][e] * v[j][e]; }
        const float rstd = __builtin_amdgcn_rsqf(wave_sum(q) * (1.f / DM) + EPS);
#pragma unroll
        for (int j = 0; j < 4; ++j) { const int c0 = 8 * (F.lane + 64 * j); float o[8], r[8];
#pragma unroll
            for (int e = 0; e < 8; ++e) o[e] = v[j][e] * rstd * lgv[j][e] + lbv[j][e];
            float* go = F.out + O_GV + (size_t)b * DM + c0;
#pragma unroll
            for (int hh = 0; hh < 2; ++hh) { const f32x4 uv = pu[0][j][hh] + pu[1][j][hh];
                *(GAS f32x4*)(go + 4 * hh) = (f32x4){o[4 * hh], o[4 * hh + 1], o[4 * hh + 2], o[4 * hh + 3]};
                r[4 * hh] = gelu_tanh_f(uv.x) * (wv[j] * o[4 * hh] + bv[j]); r[4 * hh + 1] = gelu_tanh_f(uv.y) * (wv[j] * o[4 * hh + 1] + bv[j]);
                r[4 * hh + 2] = gelu_tanh_f(uv.z) * (wv[j] * o[4 * hh + 2] + bv[j]); r[4 * hh + 3] = gelu_tanh_f(uv.w) * (wv[j] * o[4 * hh + 3] + bv[j]); }
            v4u w; w.x = cvt_pk_bf16(r[0], r[1]); w.y = cvt_pk_bf16(r[2], r[3]); w.z = cvt_pk_bf16(r[4], r[5]); w.w = cvt_pk_bf16(r[6], r[7]); *(GAS v4u*)(A3 + (size_t)row * DM + c0) = w; }
      } }
}
constexpr int VNT_STRIDE = 136;
constexpr int SGW_OFF = 128 * VNT_STRIDE * 2, SGU_OFF = 2 * SGW_OFF;
static_assert(3 * SGW_OFF <= RING_BYTES, "SGU LDS");
__device__ __forceinline__ void sgu_phase(Frame& F, const In& in, const bf16* U, const bf16* VN, const bf16* WS, bf16* A3) {
    LAS bf16* VnT = (LAS bf16*)(F.lds + RING_OFF);
    LAS bf16* Wl = (LAS bf16*)(F.lds + RING_OFF + SGW_OFF);
    LAS bf16* Ul = (LAS bf16*)(F.lds + RING_OFF + SGU_OFF);
    const float* b_s = in.p[30];
    const int lane = F.lane, r = lane & 31, h = lane >> 5, wr = F.wave >> 2, wc = F.wave & 3;
    constexpr int NU = (MP / GMC) * GMG;
    v4u vnr[4], wq[4], uq[4];
    if (F.vcu < NU) { const int n = F.vcu >> 4, g = F.vcu & 15;
#pragma unroll
        for (int i = 0; i < 4; ++i) { const int idx = F.tid + 512 * i, sidx = idx & 127, c8 = idx >> 7, trow = idx >> 4, c16 = idx & 15;
            vnr[i] = *(const GAS v4u*)(VN + (size_t)(n * GMC + sidx) * DM + g * 128 + 8 * c8);
            wq[i] = *(const GAS v4u*)(WS + ((size_t)g * GMC + trow) * GMC + 8 * c16);
            uq[i] = *(const GAS v4u*)(U + (size_t)(n * GMC + trow) * DM + g * 128 + 8 * c16); } }
    for (int u = F.vcu; u < NU; u += F.G) { const int n = u >> 4, g = u & 15;
        float bias[2];
#pragma unroll
        for (int ti = 0; ti < 2; ++ti) bias[ti] = b_s[g * GMC + 64 * wr + 32 * ti + r];
        __syncthreads();
#pragma unroll
        for (int i = 0; i < 4; ++i) { const int idx = F.tid + 512 * i, sidx = idx & 127, c8 = idx >> 7, trow = idx >> 4, c16 = idx & 15;
            const unsigned ww[4] = {vnr[i].x, vnr[i].y, vnr[i].z, vnr[i].w};
#pragma unroll
            for (int e = 0; e < 4; ++e) { VnT[(8 * c8 + 2 * e) * VNT_STRIDE + sidx] = (bf16)(ww[e] & 0xffffu); VnT[(8 * c8 + 2 * e + 1) * VNT_STRIDE + sidx] = (bf16)(ww[e] >> 16); }
            *(LAS v4u*)(Wl + trow * VNT_STRIDE + 8 * c16) = wq[i];
            *(LAS v4u*)(Ul + trow * VNT_STRIDE + 8 * c16) = uq[i]; }
        { const int un = u + F.G; if (un < NU) { const int nn = un >> 4, gn = un & 15;
#pragma unroll
            for (int i = 0; i < 4; ++i) { const int idx = F.tid + 512 * i, sidx = idx & 127, c8 = idx >> 7, trow = idx >> 4, c16 = idx & 15;
                vnr[i] = *(const GAS v4u*)(VN + (size_t)(nn * GMC + sidx) * DM + gn * 128 + 8 * c8);
                wq[i] = *(const GAS v4u*)(WS + ((size_t)gn * GMC + trow) * GMC + 8 * c16);
                uq[i] = *(const GAS v4u*)(U + (size_t)(nn * GMC + trow) * DM + gn * 128 + 8 * c16); } } }
        __syncthreads();
#pragma unroll
        for (int ti = 0; ti < 2; ++ti) { const int t = 64 * wr + 32 * ti + r;
            f32x16 acc;
#pragma unroll
            for (int e = 0; e < 16; ++e) acc[e] = 0.f;
#pragma unroll
            for (int ks = 0; ks < 8; ++ks) { const bf16x8 af = *(const LAS bf16x8*)(VnT + (32 * wc + r) * VNT_STRIDE + 16 * ks + 8 * h);
                const bf16x8 bfv = *(const LAS bf16x8*)(Wl + t * VNT_STRIDE + 16 * ks + 8 * h);
                acc = __builtin_amdgcn_mfma_f32_32x32x16_bf16(af, bfv, acc, 0, 0, 0); }
#pragma unroll
            for (int gq = 0; gq < 4; ++gq) { LAS v2u* up = (LAS v2u*)(Ul + t * VNT_STRIDE + 32 * wc + 8 * gq + 4 * h); const v2u uw = *up;
                const float u0 = bf2f((bf16)(uw.x & 0xffffu)), u1 = bf2f((bf16)(uw.x >> 16)), u2 = bf2f((bf16)(uw.y & 0xffffu)), u3 = bf2f((bf16)(uw.y >> 16));
                v2u w; w.x = cvt_pk_bf16(u0 * (acc[4 * gq] + bias[ti]), u1 * (acc[4 * gq + 1] + bias[ti])); w.y = cvt_pk_bf16(u2 * (acc[4 * gq + 2] + bias[ti]), u3 * (acc[4 * gq + 3] + bias[ti]));
                *up = w; } }
        __syncthreads();
#pragma unroll
        for (int i = 0; i < 4; ++i) { const int idx = F.tid + 512 * i, trow = idx >> 4, c16 = idx & 15;
            const v4u w = *(const LAS v4u*)(Ul + trow * VNT_STRIDE + 8 * c16);
            *(GAS v4u*)(A3 + (size_t)(n * GMC + trow) * DM + g * 128 + 8 * c16) = w; }
    }
    __syncthreads();
}

#ifndef MK_PER_PHASE
#define MK_PER_PHASE 0
#endif
#ifndef REP_P0
#define REP_P0 1
#endif
#ifndef REP_SK
#define REP_SK 1
#endif
#ifndef REP_NORM
#define REP_NORM 1
#endif
#ifndef REP_MISC
#define REP_MISC 1
#endif
#ifndef REP_ATT
#define REP_ATT 1
#endif
#ifndef REP_CONV
#define REP_CONV 1
#endif
#ifndef REP_S5
#define REP_S5 1
#endif
#ifndef REP_GML
#define REP_GML 1
#endif
#ifndef REP_SGU
#define REP_SGU 1
#endif
#ifndef REP_BAR
#define REP_BAR 1
#endif
#ifndef REP_G1
#define REP_G1 1
#endif
#ifndef REP_G2
#define REP_G2 1
#endif
#ifndef REP_DN
#define REP_DN 1
#endif
#ifndef REP_G3
#define REP_G3 1
#endif
#ifndef REP_EPI
#define REP_EPI 1
#endif
#ifndef DN_IN_TAIL
#define DN_IN_TAIL 1
#endif
struct Args { In in; float* out; unsigned char* ws; int ph_lo, ph_hi; };

struct ColPlain { __device__ __forceinline__ int operator()(int cg, int) const { return 32 * cg; } };
struct ColCin { __device__ __forceinline__ int operator()(int cg, int b) const { return b * DM + 32 * cg; } };
struct RowPlain { __device__ __forceinline__ int operator()(int u, int) const { return 32 * u; } };
struct RowPair { __device__ __forceinline__ int operator()(int u, int b) const { return 256 * (u >> 2) + 128 * b + 32 * (u & 3); } };
struct RowCin { __device__ __forceinline__ int operator()(int u, int b) const { return b == 2 ? 2 * DM + 32 * u : 256 * (u >> 2) + 128 * b + 32 * (u & 3); } };


__global__ void __launch_bounds__(NWAVES * 64, 2) hybrid_fwd(Args args) {
    extern __shared__ __attribute__((aligned(16))) unsigned char lds[];
    Frame F;
    F.lds = (LAS unsigned char*)lds;
    F.MISC = (volatile LAS unsigned*)(F.lds + MISC_OFF);
    F.tid = threadIdx.x; F.lane = F.tid & 63; F.wave = __builtin_amdgcn_readfirstlane(F.tid >> 6);
    F.G = gridDim.x; { const int bx = blockIdx.x; F.vcu = (F.G % 8 == 0) ? (bx % 8) * (F.G / 8) + bx / 8 : bx; }
    F.ws = args.ws; F.out = args.out;
    const In& in = args.in;
    unsigned char* ws = args.ws;
    gu32* ctl = (gu32*)(ws + WS_CTL);
    for (int u = F.tid; u < (LDS_BYTES - LDSCTL_OFF) / 4; u += NWAVES * 64) ((LAS unsigned*)(F.lds + LDSCTL_OFF))[u] = 0u;
    __syncthreads();
    XcdBarrier bar; bar.bar = (unsigned*)(ctl + CW_BAR); bar.x = 0; bar.st = nullptr;
    if (!MK_PER_PHASE) bar = xcd_barrier_post((unsigned*)(ctl + CW_BAR), F.MISC + 8);
#define GRID_BAR() do { if (!MK_PER_PHASE) { for (int rb_ = 0; rb_ < REP_BAR; ++rb_) xcd_barrier(bar); } } while (0)
    const int lo = args.ph_lo, hi = args.ph_hi;
    int phase_no = 0;
#define PHASE_BEGIN if (lo <= phase_no && phase_no < hi) {
#define PHASE_END   GRID_BAR(); } ++phase_no;

    bf16* const Hb = (bf16*)(ws + WS_H); bf16* const T0 = (bf16*)(ws + WS_T0); bf16* const T1 = (bf16*)(ws + WS_T1); bf16* const T2 = (bf16*)(ws + WS_T2);
    bf16* const KB = (bf16*)(ws + WS_KB); bf16* const VB = (bf16*)(ws + WS_VB); bf16* const ACT = (bf16*)(ws + WS_ACT); bf16* const Dm = (bf16*)(ws + WS_D); float* const PSB = (float*)(ws + WS_P); unsigned* const HQ = (unsigned*)(ws + WS_HQ); float* const RS = (float*)(ws + WS_RS);
    float* const Y_OUT = args.out + O_Y; bf16* const XB = (bf16*)(ws + WS_X);
    const float* const norm_g = in.p[7];
#define NG(l, k) (norm_g + ((size_t)(l) * 6 + (k)) * DM)

    PHASE_BEGIN
        for (int rp_ = 0; rp_ < REP_P0; ++rp_) { p0_convert(F, in); if (!DN_IN_TAIL) { for (int j = 0; j < 8; ++j) cvt_job(F, in, CJ_DN + j, F.vcu * NWAVES + F.wave, F.G * NWAVES); } }
        resid_norm_fast<false, false>(F, XB, nullptr, (const bf16*)in.p[0], 0.f, nullptr, NG(0, 0), Hb, HQ, RS);
        resid_norm_rows<false, true, false>(F, in.p[0], in.p[1], XB, nullptr, nullptr, 0.f, nullptr, NG(0, 0), Hb, HQ, RS, nullptr, 0, nullptr, nullptr, MP);
    PHASE_END

#define FFN_PHASES(L, S, G_POST, G_NEXT, NEXT_Q8, LASTP) \
    PHASE_BEGIN { \
        const signed char* Wgu = (const signed char*)(ws + WS_WGU + (size_t)((L) * 2 + (S)) * SZ_WGU); const float* CSc = (const float*)(ws + WS_CS) + (size_t)((L) * 2 + (S)) * NGU; \
        pg8::Gemm g{(const bf16*)HQ, (const bf16*)Wgu, MP, NGU, DM / 2}; pg8::StaticOrder S_; S_.init(MP, NGU, F.G, (int)blockIdx.x); \
        { pg8::Unit u_;        \
          _Pragma("unroll") for (int ui_ = 0; ui_ < 6; ++ui_) if (S_.next(ui_, u_)) { const float* src_ = (F.wave < 4) ? RS + u_.pm * 256 + 64 * F.wave + F.lane : CSc + u_.pn * 256 + 64 * (F.wave - 4) + F.lane; \
              __builtin_amdgcn_global_load_lds((const unsigned*)src_, (LAS unsigned*)(F.lds + SC_OFF + (ui_ * 512 + 64 * F.wave) * 4), 4, 0, 0); } } \
        pg8::EpiPairI8 E{ACT, DFF, (const LAS float*)(F.lds + SC_OFF)}; \
        pg8::gemm_phase<pg8::EpiPairI8, pg8::StaticOrder, true, true, true>(F.lds + RING_OFF, g, S_, E); if (REP_G1 > 1) pg8::gemm_phase<pg8::EpiPairI8, pg8::StaticOrder, true, true, true>(F.lds + RING_OFF, g, S_, E); \
        { struct EpiS { bf16* act; __device__ __forceinline__ void operator()(int u, int row, int col, const float (&v)[2]) const { act[(size_t)(MP + row) * DFF + 32 * u + col] = f2bf(silu_f(v[0]) * v[1]); } }; \
          const int cut_ = ((MP / 256) * (NGU / 256)) % F.G, nt_ = F.G - cut_;        \
          for (int rs_ = 0; rs_ < REP_SK; ++rs_) skinny_gemm_i8(F, (const signed char*)HQ + (size_t)MP * DM, RS + MP, Wgu, CSc, DFF / 32, (int)blockIdx.x >= cut_ ? (int)blockIdx.x - cut_ : DFF, nt_, EpiS{ACT}); \
          if (DN_IN_TAIL) for (int rc_ = 0; rc_ < REP_DN; ++rc_) { if ((int)blockIdx.x >= cut_) cvt_job(F, in, CJ_DN + (L) * 2 + (S), ((int)blockIdx.x - cut_) * NWAVES + F.wave, nt_ * NWAVES);     \
          else if (cut_ == 0) cvt_job(F, in, CJ_DN + (L) * 2 + (S), (int)blockIdx.x * NWAVES + F.wave, F.G * NWAVES); } } \
    } PHASE_END \
    PHASE_BEGIN { \
        const bf16* Wdn = (const bf16*)(ws + WS_WDN + (size_t)((L) * 2 + (S)) * SZ_WDN); \
        for (int rs_ = 0; rs_ < REP_SK; ++rs_) skinny_ks<1>(F, ACT + (size_t)MP * DFF, DFF, Wdn, DFF, DM / 32, 4, RowPlain{}, ColPlain{}, PSB, DM); \
        pg8::Gemm g{ACT, Wdn, MP, DM, DFF}; pg8::StaticOrder S_; S_.init(MP, DM, F.G, (int)blockIdx.x); \
        pg8::EpiSplit<0> E{Dm, DM, 1 << 20, nullptr, 0, 0, nullptr, 0}; \
        pg8::gemm_phase<pg8::EpiSplit<0>, pg8::StaticOrder, true, true>(F.lds + RING_OFF, g, S_, E); if (REP_G2 > 1) pg8::gemm_phase<pg8::EpiSplit<0>, pg8::StaticOrder, true, true>(F.lds + RING_OFF, g, S_, E); \
    } PHASE_END \
    PHASE_BEGIN \
        resid_norm_fast<(LASTP) != 0>(F, XB, Y_OUT, Dm, 0.5f, G_POST, G_NEXT, Hb, (NEXT_Q8) ? HQ : nullptr, RS); \
        resid_norm_sample_wg<(LASTP) != 0>(F, XB, Y_OUT, 0.5f, G_POST, G_NEXT, Hb, (NEXT_Q8) ? HQ : nullptr, RS, PSB, nullptr, nullptr); \
        for (int rn_ = 1; rn_ < REP_NORM; ++rn_) resid_norm_fast<(LASTP) != 0>(F, XB, Y_OUT, Dm, (LASTP) ? 0.5f : 0.0f, G_POST, G_NEXT, Hb, (NEXT_Q8) ? HQ : nullptr, RS); \
    PHASE_END

#define OUTPROJ_PHASES(L, A_BUF, W_OFF) \
    PHASE_BEGIN { \
        const bf16* W = (const bf16*)(ws + (W_OFF)); \
        for (int rs_ = 0; rs_ < REP_SK; ++rs_) skinny_ks<1>(F, (A_BUF) + (size_t)MP * DM, DM, W, DM, DM / 32, 4, RowPlain{}, ColPlain{}, PSB, DM); \
        pg8::Gemm g{(A_BUF), W, MP, DM, DM}; pg8::StaticOrder S_; S_.init(MP, DM, F.G, (int)blockIdx.x); \
        pg8::EpiSplit<0> E{Dm, DM, 1 << 20, nullptr, 0, 0, nullptr, 0}; \
        pg8::gemm_phase<pg8::EpiSplit<0>, pg8::StaticOrder, true, true>(F.lds + RING_OFF, g, S_, E); if (REP_G3 > 1) pg8::gemm_phase<pg8::EpiSplit<0>, pg8::StaticOrder, true, true>(F.lds + RING_OFF, g, S_, E); \
    } PHASE_END \
    PHASE_BEGIN \
        resid_norm_fast<false>(F, XB, nullptr, Dm, 1.0f, NG(L, 3), NG(L, 4), Hb, HQ, RS); \
        resid_norm_sample_wg<false>(F, XB, nullptr, 1.0f, NG(L, 3), NG(L, 4), Hb, HQ, RS, PSB, nullptr, nullptr); \
        for (int rn_ = 1; rn_ < REP_NORM; ++rn_) resid_norm_fast<false>(F, XB, nullptr, Dm, 0.0f, NG(L, 3), NG(L, 4), Hb, HQ, RS); \
    PHASE_END

    FFN_PHASES(0, 0, NG(0, 1), NG(0, 2), 0, 0)
    PHASE_BEGIN {
        const bf16* W = (const bf16*)(ws + WS_WQKV);
        pg8::Gemm g{Hb, W, MP, NQKV, DM}; pg8::StaticOrder S_; S_.init(MP, NQKV, F.G, (int)blockIdx.x);
        pg8::EpiSplit<0> E{T0, DM, 8, KB, 256, 1, VB, 256};
        pg8::gemm_phase<pg8::EpiSplit<0>, pg8::StaticOrder, true, true>(F.lds + RING_OFF, g, S_, E); if (REP_G3 > 1) pg8::gemm_phase<pg8::EpiSplit<0>, pg8::StaticOrder, true, true>(F.lds + RING_OFF, g, S_, E);
        { struct EpiS { bf16 *q, *k, *v; __device__ __forceinline__ void operator()(int u, int row, int col, const float (&x)[1]) const { const int c = 32 * u + col; const size_t r = (size_t)(MP + row);
              if (c < DM) q[r * DM + c] = f2bf(x[0]); else if (c < DM + 256) k[r * 256 + c - DM] = f2bf(x[0]); else v[r * 256 + c - DM - 256] = f2bf(x[0]); } };
          const int cut_ = ((MP / 256) * (NQKV / 256)) % F.G, nt_ = F.G - cut_;
          for (int rs_ = 0; rs_ < REP_SK; ++rs_) skinny_gemm<1>(F, Hb + (size_t)MP * DM, DM, W, DM, NQKV / 32, (int)blockIdx.x >= cut_ ? (int)blockIdx.x - cut_ : NQKV, nt_, RowPlain{}, EpiS{T0, KB, VB});
          if ((int)blockIdx.x >= cut_ || cut_ == 0) { const int wi_ = (cut_ == 0 ? (int)blockIdx.x : (int)blockIdx.x - cut_) * NWAVES + F.wave, nw_ = (cut_ == 0 ? F.G : nt_) * NWAVES;
              cvt_job(F, in, CJ_O, wi_, nw_); cvt_job(F, in, CJ_CIN, wi_, nw_); cvt_job(F, in, CJ_COUT, wi_, nw_); } }
    } PHASE_END
    PHASE_BEGIN
        for (int rm_ = 0; rm_ < REP_MISC * REP_ATT; ++rm_) { attn_phase_all(F, in, T0, KB, VB, T1); }
    PHASE_END
    OUTPROJ_PHASES(0, T1, WS_WO)
    FFN_PHASES(0, 1, NG(0, 5), NG(1, 0), 1, 0)

    FFN_PHASES(1, 0, NG(1, 1), NG(1, 2), 0, 0)
    PHASE_BEGIN {
        const bf16* W = (const bf16*)(ws + WS_WCIN);
        for (int rs_ = 0; rs_ < REP_SK; ++rs_) skinny_ks<3>(F, Hb + (size_t)MP * DM, DM, W, DM, DM / 32, 4, RowCin{}, ColCin{}, PSB, 3 * DM);
        pg8::Gemm g{Hb, W, MP, 3 * DM, DM}; pg8::StaticOrder S_; S_.init(MP, 3 * DM, F.G, (int)blockIdx.x);
        pg8::EpiPair<1> E{T0, DM, 16, T1, DM};
        pg8::gemm_phase<pg8::EpiPair<1>, pg8::StaticOrder, true, true>(F.lds + RING_OFF, g, S_, E); if (REP_G3 > 1) pg8::gemm_phase<pg8::EpiPair<1>, pg8::StaticOrder, true, true>(F.lds + RING_OFF, g, S_, E);
    } PHASE_END
    PHASE_BEGIN
        for (int rm_ = 0; rm_ < REP_MISC * REP_CONV; ++rm_) { conv_pass(F, in, T0, T1, T2, PSB, 4); }
    PHASE_END
    OUTPROJ_PHASES(1, T2, WS_WCOUT)
    FFN_PHASES(1, 1, NG(1, 5), NG(2, 0), 1, 0)

    FFN_PHASES(2, 0, NG(2, 1), NG(2, 2), 0, 0)
    PHASE_BEGIN
        s5_phase<0>(F, in, Hb, T0); for (int rm_ = 1; rm_ < REP_MISC * REP_S5; ++rm_) { s5_phase<S5_XMODE>(F, in, Hb, T0); }
    PHASE_END
    PHASE_BEGIN {
        const bf16* W = (const bf16*)(ws + WS_WGATE);
        for (int rs_ = 0; rs_ < REP_SK; ++rs_) skinny_ks<1>(F, T0 + (size_t)MP * DM, DM, W, DM, DM / 32, 4, RowPlain{}, ColPlain{}, PSB, DM);
        pg8::Gemm g{T0, W, MP, DM, DM}; pg8::StaticOrder S_; S_.init(MP, DM, F.G, (int)blockIdx.x);
        pg8::EpiGate E{Dm, T0, in.p[25], DM};
        pg8::gemm_phase<pg8::EpiGate, pg8::StaticOrder, true, true>(F.lds + RING_OFF, g, S_, E); if (REP_G3 > 1) pg8::gemm_phase<pg8::EpiGate, pg8::StaticOrder, true, true>(F.lds + RING_OFF, g, S_, E);
    } PHASE_END
    PHASE_BEGIN
        resid_norm_fast<false>(F, XB, nullptr, Dm, 1.0f, NG(2, 3), NG(2, 4), Hb, HQ, RS);
        resid_norm_sample_wg<false>(F, XB, nullptr, 1.0f, NG(2, 3), NG(2, 4), Hb, HQ, RS, PSB, T0, in.p[25]);
        for (int rn_ = 1; rn_ < REP_NORM; ++rn_) resid_norm_fast<false>(F, XB, nullptr, Dm, 0.0f, NG(2, 3), NG(2, 4), Hb, HQ, RS);
    PHASE_END
    FFN_PHASES(2, 1, NG(2, 5), NG(3, 0), 1, 0)

    FFN_PHASES(3, 0, NG(3, 1), NG(3, 2), 0, 0)
    PHASE_BEGIN {
        const bf16* W = (const bf16*)(ws + WS_WUV);
        for (int rs_ = 0; rs_ < REP_SK; ++rs_) skinny_ks<1>(F, Hb + (size_t)MP * DM, DM, W, DM, 2 * DM / 32, 2, RowPlain{}, ColPlain{}, PSB, 2 * DM);
        pg8::Gemm g{Hb, W, MP, 2 * DM, DM}; pg8::StaticOrder S_; S_.init(MP, 2 * DM, F.G, (int)blockIdx.x);
        pg8::EpiSplit<1> E{T0, DM, 8, T1, DM, 8, nullptr, 0};
        pg8::gemm_phase<pg8::EpiSplit<1>, pg8::StaticOrder, true, true>(F.lds + RING_OFF, g, S_, E); if (REP_G3 > 1) pg8::gemm_phase<pg8::EpiSplit<1>, pg8::StaticOrder, true, true>(F.lds + RING_OFF, g, S_, E);
    } PHASE_END
    PHASE_BEGIN
        for (int rm_ = 0; rm_ < REP_MISC * REP_GML; ++rm_) { gm_ln_pass(F, in, T0, T1, T2, Hb, PSB, 2); }
    PHASE_END
    PHASE_BEGIN
        for (int rm_ = 0; rm_ < REP_MISC * REP_SGU; ++rm_) { sgu_phase(F, in, T0, T2, (const bf16*)(ws + WS_WS), Hb); }
    PHASE_END
    OUTPROJ_PHASES(3, Hb, WS_WGOUT)
    FFN_PHASES(3, 1, NG(3, 5), nullptr, 0, 1)
#undef NG
}
constexpr int N_PHASES = 1 + 8 * 3 + (2 + 2) + (2 + 2) + (2 + 1) + (3 + 2);

extern "C" void kernel_launch(void* const* d_in, const int* in_sizes, int n_in, void* d_out, int out_size, void* d_ws, size_t ws_size, hipStream_t stream) {
    static int grid = 0;
    if (grid == 0) {
        if (n_in != 32 || (size_t)out_size != O_END || ws_size < WS_END) { fprintf(stderr, "kernel_launch: unexpected sizes: n_in %d out %d (want %zu) ws %zu (want >= %zu); nothing launched\n", n_in, out_size, (size_t)O_END, ws_size, (size_t)WS_END); grid = -1; return; }
        int dev = 0, cus = 0, per_cu = 0;
        if (hipGetDevice(&dev) != hipSuccess || hipDeviceGetAttribute(&cus, hipDeviceAttributeMultiprocessorCount, dev) != hipSuccess) { grid = -1; return; }
        if (hipFuncSetAttribute((const void*)hybrid_fwd, hipFuncAttributeMaxDynamicSharedMemorySize, LDS_BYTES) != hipSuccess) { fprintf(stderr, "kernel_launch: hipFuncSetAttribute failed\n"); grid = -1; return; }
        if (hipOccupancyMaxActiveBlocksPerMultiprocessor(&per_cu, (const void*)hybrid_fwd, NWAVES * 64, LDS_BYTES) != hipSuccess || per_cu < 1) { fprintf(stderr, "kernel_launch: occupancy query says %d blocks per CU\n", per_cu); }
        (void)hipGetLastError();
        grid = cus;
    }
    if (grid < 0) return;
    (void)hipMemsetAsync((char*)d_ws + WS_CTL, 0, CTL_ZERO_BYTES, stream);
    Args a{};
    for (int i = 0; i < 32; ++i) a.in.p[i] = (const float*)d_in[i];
    a.out = (float*)d_out; a.ws = (unsigned char*)d_ws;
#if MK_PER_PHASE
    for (int p = 0; p < N_PHASES; ++p) { a.ph_lo = p; a.ph_hi = p + 1; hipLaunchKernelGGL(hybrid_fwd, dim3(grid), dim3(NWAVES * 64), LDS_BYTES, stream, a); }
#else
    a.ph_lo = 0; a.ph_hi = N_PHASES;
    hipLaunchKernelGGL(hybrid_fwd, dim3(grid), dim3(NWAVES * 64), LDS_BYTES, stream, a);
#endif
}
```

```cpp
#include <hip/hip_runtime.h>
#include <cstdio>
#include <cstdint>
namespace pg8 {
#define PG8_LAS __attribute__((address_space(3)))
typedef unsigned short bf16_t;
typedef short bf16x8 __attribute__((ext_vector_type(8)));
typedef float f32x4 __attribute__((ext_vector_type(4)));
typedef unsigned u32x4 __attribute__((ext_vector_type(4)));
typedef int i32x4 __attribute__((ext_vector_type(4)));
constexpr int BM = 256, BK = 64, HALF = 128, HTB = HALF * BK * 2  , STAGE_BYTES = 8 * HTB, NXCD = 8, WGM = 8;

__host__ __device__ __forceinline__ int lds_byte(int r, int c) { const int st = (r >> 4) * 2 + (c >> 5), rr = r & 15, cc = c & 31, ob = rr * 64 + cc * 2; return st * 1024 + (ob ^ (((ob >> 9) & 1) << 5)); }
__host__ __device__ __forceinline__ void stage_rc(int b, int& R, int& C) { const int st = b / 1024, sb = b % 1024, swz = sb ^ (((sb >> 9) & 1) << 5); R = (st >> 1) * 16 + swz / 64; C = (st & 1) * 32 + (swz % 64) / 2; }
__host__ __device__ __forceinline__ int perm32(int rho) { const int n = rho >> 4, i = rho & 15; return 8 * (i >> 2) + 4 * n + (i & 3); }

struct Unit { int pm, pn; };
struct Gemm { const bf16_t* A; const bf16_t* Bt; int M, N, K; };

struct StaticOrder {
    int nM, nN, nwg, G, c;
    __host__ __device__ void init(int M, int N, int G_, int c_) { nM = M / BM; nN = N / BM; nwg = nM * nN; G = G_; c = c_; }
    __host__ __device__ __forceinline__ bool next(int i, Unit& u) const {
        const long L = (long)i * G + c; if (L >= nwg) return false;
        int wgid = (int)L; { const int q = nwg / NXCD, r = nwg % NXCD, xcd = wgid % NXCD, off = wgid / NXCD; wgid = (xcd < r ? xcd * (q + 1) : r * (q + 1) + (xcd - r) * q) + off; }
        const int nig = WGM * nN, gid = wgid / nig, fm = gid * WGM, gsz = (nM - fm) < WGM ? (nM - fm) : WGM;
        u.pm = fm + ((wgid % nig) % gsz); u.pn = (wgid % nig) / gsz; return true;
    }
    __device__ __forceinline__ void a_ready(const Unit&) const {}
    __device__ __forceinline__ void done(const Unit&) const {}
};


__device__ __forceinline__ unsigned cvt_pk_bf16(float lo, float hi) { unsigned r; asm volatile("v_cvt_pk_bf16_f32 %0, %1, %2" : "=v"(r) : "v"(lo), "v"(hi)); return r; }
__device__ __forceinline__ float fast_sigmoid(float v) { return __builtin_amdgcn_rcpf(1.0f + __builtin_amdgcn_exp2f(-1.4426950408889634f * v)); }
__device__ __forceinline__ float silu_f(float v) { return v * fast_sigmoid(v); }
typedef float f32x2_t __attribute__((ext_vector_type(2)));
__device__ __forceinline__ f32x2_t gelu_tanh_pk(f32x2_t v) {
    const f32x2_t p = (v * v) * -0.10294324064f + -2.30220819814f;
    const f32x2_t a = v * p;
    const f32x2_t d = (f32x2_t){__builtin_amdgcn_exp2f(a.x), __builtin_amdgcn_exp2f(a.y)} + 1.0f;
    return v * (f32x2_t){__builtin_amdgcn_rcpf(d.x), __builtin_amdgcn_rcpf(d.y)};
}
__device__ __forceinline__ float gelu_tanh_f(float v) { const float t = v * (1.0f + 0.044715f * v * v) * 1.5957691216057308f; return v * fast_sigmoid(t); }
__device__ __forceinline__ float bf2f(unsigned short b) { return __builtin_bit_cast(float, (unsigned)b << 16); }

struct EpiF32 {
    static constexpr bool PERM = false, AFTER_DRAIN = false;
    float* C; int ldc;
    __device__ __forceinline__ void operator()(const f32x4 (&acc)[2][2][4][2], const Unit& u, int wr, int wc, int fr, int fq) const {
        const int row0 = u.pm * BM + wr * 64 + fr, col0 = u.pn * BM + wc * 32 + 4 * fq;
#pragma unroll
        for (int ai = 0; ai < 2; ++ai)
#pragma unroll
            for (int m = 0; m < 4; ++m) { float* rowp = C + (size_t)(row0 + ai * HALF + m * 16) * ldc + col0;
#pragma unroll
                for (int bj = 0; bj < 2; ++bj)
#pragma unroll
                    for (int n = 0; n < 2; ++n) *(f32x4*)(rowp + bj * HALF + n * 16) = acc[ai][bj][m][n]; }
    }
};
struct EpiGate {
    static constexpr bool PERM = true, AFTER_DRAIN = false;
    bf16_t* C; const bf16_t* Z; const float* bias; int ldc;
    __device__ __forceinline__ void operator()(const f32x4 (&acc)[2][2][4][2], const Unit& u, int wr, int wc, int fr, int fq) const {
        const int row0 = u.pm * BM + wr * 64 + fr, col0 = u.pn * BM + wc * 32 + 8 * fq;
        f32x4 bv[2][2];
#pragma unroll
        for (int bj = 0; bj < 2; ++bj)
#pragma unroll
            for (int n = 0; n < 2; ++n) bv[bj][n] = *(const f32x4*)(bias + col0 + bj * HALF + 4 * n);
#pragma unroll
        for (int ai = 0; ai < 2; ++ai) {
            u32x4 zq[4][2];
#pragma unroll
            for (int m = 0; m < 4; ++m)
#pragma unroll
                for (int bj = 0; bj < 2; ++bj) zq[m][bj] = *(const u32x4*)(Z + (size_t)(row0 + ai * HALF + m * 16) * ldc + col0 + bj * HALF);
#pragma unroll
            for (int m = 0; m < 4; ++m) { const size_t off = (size_t)(row0 + ai * HALF + m * 16) * ldc + col0;
#pragma unroll
                for (int bj = 0; bj < 2; ++bj) { const u32x4 zz = zq[m][bj]; const unsigned zw[4] = {zz.x, zz.y, zz.z, zz.w}; float o[8];
#pragma unroll
                    for (int n = 0; n < 2; ++n)
#pragma unroll
                        for (int e = 0; e < 4; ++e) { const unsigned w = zw[2 * n + (e >> 1)]; const float zv = bf2f((unsigned short)((e & 1) ? (w >> 16) : (w & 0xffffu))); o[4 * n + e] = zv * fast_sigmoid(acc[ai][bj][m][n][e] + bv[bj][n][e]); }
                    u32x4 w; w.x = cvt_pk_bf16(o[0], o[1]); w.y = cvt_pk_bf16(o[2], o[3]); w.z = cvt_pk_bf16(o[4], o[5]); w.w = cvt_pk_bf16(o[6], o[7]);
                    *(u32x4*)(C + off + bj * HALF) = w; } } }
    }
};
template <int MODE> struct EpiPair {
    static constexpr bool PERM = true, AFTER_DRAIN = false;
    bf16_t* O; int ldc; int npair; bf16_t* O2; int ldc2;
    __device__ __forceinline__ void operator()(const f32x4 (&acc)[2][2][4][2], const Unit& u, int wr, int wc, int fr, int fq) const {
        const int row0 = u.pm * BM + wr * 64 + fr;
        if (u.pn < npair) {
            const int col0 = u.pn * HALF + wc * 32 + 8 * fq;
#ifdef REP_EPI_PAIR
#pragma unroll 1
            for (int rep_ = 0; rep_ < REP_EPI_PAIR; ++rep_)
#endif
#pragma unroll
            for (int ai = 0; ai < 2; ++ai)
#pragma unroll
                for (int m = 0; m < 4; ++m) { bf16_t* rowp = O + (size_t)(row0 + ai * HALF + m * 16) * ldc + col0;
                    float r[8];
#pragma unroll
                    for (int n = 0; n < 2; ++n)
#pragma unroll
                        for (int e = 0; e < 4; ++e) { const float a = acc[ai][0][m][n][e], b = acc[ai][1][m][n][e]; r[4 * n + e] = (MODE == 0 ? silu_f(a) : a) * b; }
                    u32x4 w; w.x = cvt_pk_bf16(r[0], r[1]); w.y = cvt_pk_bf16(r[2], r[3]); w.z = cvt_pk_bf16(r[4], r[5]); w.w = cvt_pk_bf16(r[6], r[7]);
                    *(u32x4*)rowp = w; }
        } else {
            const int col0 = (u.pn - npair) * BM + wc * 32 + 8 * fq;
#pragma unroll
            for (int ai = 0; ai < 2; ++ai)
#pragma unroll
                for (int m = 0; m < 4; ++m) { bf16_t* rowp = O2 + (size_t)(row0 + ai * HALF + m * 16) * ldc2 + col0;
#pragma unroll
                    for (int bj = 0; bj < 2; ++bj) { const f32x4 v0 = acc[ai][bj][m][0], v1 = acc[ai][bj][m][1];
                        u32x4 w; w.x = cvt_pk_bf16(v0[0], v0[1]); w.y = cvt_pk_bf16(v0[2], v0[3]); w.z = cvt_pk_bf16(v1[0], v1[1]); w.w = cvt_pk_bf16(v1[2], v1[3]);
                        *(u32x4*)(rowp + bj * HALF) = w; } }
        }
    }
};
template <int ACT> struct EpiSplit {
    static constexpr bool PERM = true, AFTER_DRAIN = false;
    bf16_t* O0; int ld0, n0; bf16_t* O1; int ld1, n1; bf16_t* O2; int ld2;
    __device__ __forceinline__ void operator()(const f32x4 (&acc)[2][2][4][2], const Unit& u, int wr, int wc, int fr, int fq) const {
        const int row0 = u.pm * BM + wr * 64 + fr;
        bf16_t* base; int ld, t = u.pn;
        if (t < n0) { base = O0; ld = ld0; } else if (t - n0 < n1) { base = O1; ld = ld1; t -= n0; } else { base = O2; ld = ld2; t -= n0 + n1; }
        const int col0 = t * BM + wc * 32 + 8 * fq;
#pragma unroll
        for (int ai = 0; ai < 2; ++ai)
#pragma unroll
            for (int m = 0; m < 4; ++m) { bf16_t* rowp = base + (size_t)(row0 + ai * HALF + m * 16) * ld + col0;
#pragma unroll
                for (int bj = 0; bj < 2; ++bj) { f32x4 v0 = acc[ai][bj][m][0], v1 = acc[ai][bj][m][1];
                    if (ACT == 1) { const f32x2_t a0 = gelu_tanh_pk((f32x2_t){v0.x, v0.y}), a1 = gelu_tanh_pk((f32x2_t){v0.z, v0.w}), b0 = gelu_tanh_pk((f32x2_t){v1.x, v1.y}), b1 = gelu_tanh_pk((f32x2_t){v1.z, v1.w});
                        v0 = (f32x4){a0.x, a0.y, a1.x, a1.y}; v1 = (f32x4){b0.x, b0.y, b1.x, b1.y}; }
                    u32x4 w; w.x = cvt_pk_bf16(v0[0], v0[1]); w.y = cvt_pk_bf16(v0[2], v0[3]); w.z = cvt_pk_bf16(v1[0], v1[1]); w.w = cvt_pk_bf16(v1[2], v1[3]);
                    *(u32x4*)(rowp + bj * HALF) = w; } }
    }
};


struct EpiPairI8 {
    static constexpr bool PERM = true, AFTER_DRAIN = false;
    bf16_t* O; int ldc; const PG8_LAS float* sc;
    __device__ __forceinline__ void operator()(const i32x4 (&acc)[2][2][4][2], const Unit& u, int wr, int wc, int fr, int fq, int ui) const {
        typedef float f32x2 __attribute__((ext_vector_type(2)));
        const PG8_LAS float* s = sc + ui * 512;
        const int rl = wr * 64 + fr, col0 = u.pn * HALF + wc * 32 + 8 * fq, lc = 256 + wc * 32 + 8 * fq;
        f32x2 ca[2][2], cab[2][2];
#pragma unroll
        for (int n = 0; n < 2; ++n) { const f32x4 a = *(const PG8_LAS f32x4*)(s + lc + 4 * n), b = *(const PG8_LAS f32x4*)(s + lc + HALF + 4 * n);
            ca[n][0] = (f32x2){a.x, a.y} * -1.4426950408889634f; ca[n][1] = (f32x2){a.z, a.w} * -1.4426950408889634f;
            cab[n][0] = (f32x2){a.x, a.y} * (f32x2){b.x, b.y}; cab[n][1] = (f32x2){a.z, a.w} * (f32x2){b.z, b.w}; }
#ifdef REP_EPI_PAIR
#pragma unroll 1
        for (int rep_ = 0; rep_ < REP_EPI_PAIR; ++rep_)
#endif
#pragma unroll
        for (int ai = 0; ai < 2; ++ai)
#pragma unroll
            for (int m = 0; m < 4; ++m) { const int lr = rl + ai * HALF + m * 16; bf16_t* rowp = O + (size_t)(u.pm * BM + lr) * ldc + col0; const float rsc = s[lr], rsq = rsc * rsc;
                u32x4 w;
#pragma unroll
                for (int n = 0; n < 2; ++n)
#pragma unroll
                    for (int e2 = 0; e2 < 2; ++e2) {
                        const f32x2 ia = (f32x2){(float)acc[ai][0][m][n][2 * e2], (float)acc[ai][0][m][n][2 * e2 + 1]}, ib = (f32x2){(float)acc[ai][1][m][n][2 * e2], (float)acc[ai][1][m][n][2 * e2 + 1]};
                        const f32x2 t = ia * (ca[n][e2] * rsc);
                        const f32x2 d = (f32x2){__builtin_amdgcn_exp2f(t.x), __builtin_amdgcn_exp2f(t.y)} + 1.0f;
                        const f32x2 r = (f32x2){__builtin_amdgcn_rcpf(d.x), __builtin_amdgcn_rcpf(d.y)};
                        const f32x2 o = ((ia * ib) * (cab[n][e2] * rsq)) * r;
                        w[2 * n + e2] = cvt_pk_bf16(o.x, o.y); }
                *(u32x4*)rowp = w; asm volatile("" ::: "memory"); }
    }
};
template <class E> struct EpiWantsUi { static constexpr bool value = false; };
template <> struct EpiWantsUi<EpiPairI8> { static constexpr bool value = true; };
template <bool I8> struct AccSel { typedef f32x4 T; };
template <> struct AccSel<true> { typedef i32x4 T; };
__device__ __forceinline__ f32x4 mma1(bf16x8 a, bf16x8 b, f32x4 c) { return __builtin_amdgcn_mfma_f32_16x16x32_bf16(a, b, c, 0, 0, 0); }
__device__ __forceinline__ i32x4 mma1(bf16x8 a, bf16x8 b, i32x4 c) { return __builtin_amdgcn_mfma_i32_16x16x64_i8(__builtin_bit_cast(i32x4, a), __builtin_bit_cast(i32x4, b), c, 0, 0, 0); }
template <class Epi, class Sched, bool ALIGN_EPI = false, bool SP2 = false, bool I8 = false>
__device__ __forceinline__ void gemm_phase(PG8_LAS unsigned char* lds, const Gemm g, const Sched& S, const Epi& E) {
    const int tid = threadIdx.x, wid = __builtin_amdgcn_readfirstlane(tid >> 6), lane = tid & 63, wr = wid >> 2, wc = wid & 3, fr = lane & 15, fq = lane >> 4;
    const int K = g.K, nt = K / BK;
    unsigned voffA[2], voffB[2];
#pragma unroll
    for (int i = 0; i < 2; ++i) { int R, C; stage_rc(tid * 16 + i * 8192, R, C); const int Rb = Epi::PERM ? ((R & ~31) + perm32(R & 31)) : R;
        voffA[i] = (unsigned)(R * K + C) * 2u; voffB[i] = (unsigned)(Rb * K + C) * 2u; }
    const size_t kstep = (size_t)(BK * 2);
    const size_t hstep = (size_t)HALF * K * 2;
    const size_t tstep = 2 * hstep;
    const unsigned ldsw = (unsigned)wid * 1024u;
    const int aoff = lds_byte(wr * 64 + fr, fq * 8), boff = lds_byte(wc * 32 + fr, fq * 8);
#define PG8_SA(b, h) (((b) * 2 + (h)) * HTB)
#define PG8_SB(b, h) ((4 + (b) * 2 + (h)) * HTB)
#define PG8_STAGE(bufoff, gbase, voff) do { _Pragma("unroll") for (int _i = 0; _i < 2; ++_i) \
        __builtin_amdgcn_global_load_lds((const unsigned*)((const char*)(gbase) + (voff)[_i]), (PG8_LAS unsigned*)(lds + (bufoff) + ldsw + _i * 8192), 16, 0, 0); } while (0)
#define PG8_LDA(dst, b, h) do { _Pragma("unroll") for (int m = 0; m < 4; ++m) _Pragma("unroll") for (int k = 0; k < 2; ++k) dst[m][k] = *(const PG8_LAS bf16x8*)(lds + PG8_SA(b, h) + aoff + m * 2048 + k * 1024); } while (0)
#define PG8_LDB(dst, b, h) do { _Pragma("unroll") for (int n = 0; n < 2; ++n) _Pragma("unroll") for (int k = 0; k < 2; ++k) dst[n][k] = *(const PG8_LAS bf16x8*)(lds + PG8_SB(b, h) + boff + n * 2048 + k * 1024); } while (0)
#define PG8_MMA(ai, bj, At, Bt) do { __builtin_amdgcn_s_setprio(1); _Pragma("unroll") for (int m = 0; m < 4; ++m) _Pragma("unroll") for (int n = 0; n < 2; ++n) _Pragma("unroll") for (int k = 0; k < 2; ++k) \
        acc[ai][bj][m][n] = mma1(Bt[n][k], At[m][k], acc[ai][bj][m][n]); __builtin_amdgcn_s_setprio(0); } while (0)
#define PG8_WAIT_V(n) asm volatile("s_waitcnt vmcnt(" #n ")" ::: "memory")
#define PG8_WAIT_L(n) asm volatile("s_waitcnt lgkmcnt(" #n ")" ::: "memory")
#define PG8_BAR __builtin_amdgcn_s_barrier()
#define PG8_SCHED __builtin_amdgcn_sched_barrier(0)
    Unit cur, nxt; int ui = 0;
    if (!S.next(0, cur)) return;
    typedef typename AccSel<I8>::T AccT;
    AccT acc[2][2][4][2];
#pragma unroll
    for (int a = 0; a < 2; ++a)
#pragma unroll
        for (int b = 0; b < 2; ++b)
#pragma unroll
            for (int m = 0; m < 4; ++m)
#pragma unroll
                for (int n = 0; n < 2; ++n) acc[a][b][m][n] = (AccT){0, 0, 0, 0};
    bf16x8 At[4][2], B0[2][2], B1[2][2];
    const char* cA = (const char*)g.A + (size_t)cur.pm * tstep; const char* cB = (const char*)g.Bt + (size_t)cur.pn * tstep;
    S.a_ready(cur);
    if constexpr (SP2) {
        PG8_STAGE(PG8_SB(0, 0), cB, voffB); PG8_STAGE(PG8_SB(0, 1), cB + hstep, voffB); PG8_STAGE(PG8_SA(0, 0), cA, voffA); PG8_STAGE(PG8_SA(0, 1), cA + hstep, voffA);
        PG8_STAGE(PG8_SB(1, 0), cB + kstep, voffB); PG8_STAGE(PG8_SA(1, 0), cA + kstep, voffA); PG8_STAGE(PG8_SB(1, 1), cB + hstep + kstep, voffB);
        if (wr == 1) PG8_BAR;
        PG8_WAIT_V(8); PG8_BAR;
        PG8_WAIT_V(6); PG8_BAR;
    } else {
        PG8_STAGE(PG8_SB(0, 0), cB, voffB); PG8_STAGE(PG8_SA(0, 0), cA, voffA); PG8_STAGE(PG8_SB(0, 1), cB + hstep, voffB); PG8_STAGE(PG8_SA(0, 1), cA + hstep, voffA);
        if (wr == 1) PG8_BAR;
        PG8_WAIT_V(4); PG8_BAR;
        PG8_STAGE(PG8_SB(1, 0), cB + kstep, voffB); PG8_STAGE(PG8_SA(1, 0), cA + kstep, voffA); PG8_STAGE(PG8_SB(1, 1), cB + hstep + kstep, voffB);
        PG8_WAIT_V(6); PG8_BAR;
    }
    for (;;) {
        const bool has_next = S.next(ui + 1, nxt);
        const char* nA = has_next ? (const char*)g.A + (size_t)nxt.pm * tstep : cA; const char* nB = has_next ? (const char*)g.Bt + (size_t)nxt.pn * tstep : cB;
        for (int t = 0; t < nt; t += 2) {
            const bool last = (t == nt - 2);
            const char* a1 = cA + (size_t)(t + 1) * kstep;
            const char* a2 = last ? nA : cA + (size_t)(t + 2) * kstep; const char* b2 = last ? nB : cB + (size_t)(t + 2) * kstep;
            const char* a3 = a2 + kstep; const char* b3 = b2 + kstep;
            if (last && has_next) S.a_ready(nxt);
            if constexpr (SP2) {
            PG8_LDB(B0, 0, 0); PG8_LDB(B1, 0, 1); PG8_SCHED; PG8_LDA(At, 0, 0); PG8_STAGE(PG8_SA(1, 1), a1 + hstep, voffA);
            PG8_WAIT_V(8); PG8_WAIT_L(0); PG8_BAR; PG8_MMA(0, 0, At, B0); PG8_MMA(0, 1, At, B1); PG8_BAR; PG8_SCHED;
            PG8_LDA(At, 0, 1); PG8_STAGE(PG8_SB(0, 0), b2, voffB); PG8_STAGE(PG8_SB(0, 1), b2 + hstep, voffB); PG8_STAGE(PG8_SA(0, 0), a2, voffA);
            PG8_WAIT_V(8); PG8_WAIT_L(0); PG8_BAR; PG8_MMA(1, 0, At, B0); PG8_MMA(1, 1, At, B1); PG8_BAR; PG8_SCHED;
            PG8_LDB(B0, 1, 0); PG8_LDB(B1, 1, 1); PG8_SCHED; PG8_LDA(At, 1, 0); PG8_STAGE(PG8_SA(0, 1), a2 + hstep, voffA);
            PG8_WAIT_V(8); PG8_WAIT_L(0); PG8_BAR; PG8_MMA(0, 0, At, B0); PG8_MMA(0, 1, At, B1); PG8_BAR; PG8_SCHED;
            PG8_LDA(At, 1, 1); PG8_STAGE(PG8_SB(1, 0), b3, voffB); PG8_STAGE(PG8_SB(1, 1), b3 + hstep, voffB); PG8_STAGE(PG8_SA(1, 0), a3, voffA);
            PG8_WAIT_V(8); PG8_WAIT_L(0); PG8_BAR; PG8_MMA(1, 0, At, B0); PG8_MMA(1, 1, At, B1); PG8_BAR; PG8_SCHED;
            } else {
            PG8_LDB(B0, 0, 0); PG8_SCHED; PG8_LDA(At, 0, 0); PG8_STAGE(PG8_SA(1, 1), a1 + hstep, voffA);
            PG8_WAIT_L(8); PG8_BAR; PG8_WAIT_L(0); PG8_MMA(0, 0, At, B0); PG8_BAR; PG8_SCHED;
            PG8_LDB(B1, 0, 1); PG8_STAGE(PG8_SB(0, 0), b2, voffB);
            PG8_BAR; PG8_WAIT_L(0); PG8_MMA(0, 1, At, B1); PG8_BAR;
            PG8_LDA(At, 0, 1); PG8_STAGE(PG8_SA(0, 0), a2, voffA);
            PG8_BAR; PG8_WAIT_L(0); PG8_MMA(1, 0, At, B0); PG8_BAR; PG8_SCHED;
            PG8_STAGE(PG8_SB(0, 1), b2 + hstep, voffB);
            PG8_WAIT_V(6); PG8_BAR; PG8_MMA(1, 1, At, B1); PG8_BAR;
            PG8_LDB(B0, 1, 0); PG8_SCHED; PG8_LDA(At, 1, 0); PG8_STAGE(PG8_SA(0, 1), a2 + hstep, voffA);
            PG8_WAIT_L(8); PG8_BAR; PG8_WAIT_L(0); PG8_MMA(0, 0, At, B0); PG8_BAR; PG8_SCHED;
            PG8_LDB(B1, 1, 1); PG8_STAGE(PG8_SB(1, 0), b3, voffB);
            PG8_BAR; PG8_WAIT_L(0); PG8_MMA(0, 1, At, B1); PG8_BAR;
            PG8_LDA(At, 1, 1); PG8_STAGE(PG8_SA(1, 0), a3, voffA);
            PG8_BAR; PG8_WAIT_L(0); PG8_MMA(1, 0, At, B0); PG8_BAR; PG8_SCHED;
            PG8_STAGE(PG8_SB(1, 1), b3 + hstep, voffB);
            PG8_WAIT_V(6); PG8_BAR; PG8_MMA(1, 1, At, B1); PG8_BAR;
            }
        }
        if constexpr (ALIGN_EPI) { if (wr == 0) PG8_BAR; }
        if constexpr (!Epi::AFTER_DRAIN) { if constexpr (EpiWantsUi<Epi>::value) E(acc, cur, wr, wc, fr, fq, ui); else E(acc, cur, wr, wc, fr, fq); S.done(cur); }
        if (!has_next) break;
#pragma unroll
        for (int a = 0; a < 2; ++a)
#pragma unroll
            for (int b = 0; b < 2; ++b)
#pragma unroll
                for (int m = 0; m < 4; ++m)
#pragma unroll
                    for (int n = 0; n < 2; ++n) acc[a][b][m][n] = (AccT){0, 0, 0, 0};
        cur = nxt; cA = nA; cB = nB; ++ui;
        if constexpr (ALIGN_EPI) { if (wr == 1) PG8_BAR; }
    }
    PG8_WAIT_V(0);
    if constexpr (!ALIGN_EPI) { if (wr == 0) PG8_BAR; }
    PG8_BAR;
    if constexpr (Epi::AFTER_DRAIN) { E.fused(acc, cur, wr, wc, fr, fq, lds, wid, lane); S.done(cur); }
#undef PG8_SA
#undef PG8_SB
#undef PG8_STAGE
#undef PG8_LDA
#undef PG8_LDB
#undef PG8_MMA
#undef PG8_WAIT_V
#undef PG8_WAIT_L
#undef PG8_BAR
#undef PG8_SCHED
}
}

constexpr int NWAVES = 8;
constexpr int DM = 2048, SEQ = 4096, NB_P = 2, MP = NB_P * SEQ, MS = 32, MT = MP + MS;
constexpr int DFF = 5632, NGU = 2 * DFF;
constexpr int NH = 32, NKV = 4, HD = 64, QPK = 8, WIN = 128, NQKV = (NH + 2 * NKV) * HD;
constexpr int SSG = 16, SSN = 128, SSP = 64;
constexpr int GMC = 128, GMG = 16;
constexpr float EPS = 1e-6f;
constexpr float ATTN_SCALE = 0.125f;

constexpr size_t O_Y = 0;
constexpr size_t O_KP = (size_t)MT * DM;
constexpr size_t O_VP = O_KP + 65536;
constexpr size_t O_KS = O_VP + 65536;
constexpr size_t O_VS = O_KS + 1048576;
constexpr size_t O_CP = O_VS + 1048576;
constexpr size_t O_CS = O_CP + 8192;
constexpr size_t O_SRP = O_CS + 131072;
constexpr size_t O_SIP = O_SRP + 16384;
constexpr size_t O_SRS = O_SIP + 16384;
constexpr size_t O_SIS = O_SRS + 262144;
constexpr size_t O_GV = O_SIS + 262144;
constexpr size_t O_END = O_GV + 65536;

constexpr size_t MiB = 1u << 20;
constexpr size_t WS_CTL = 0, CTL_ZERO_BYTES = 1 * MiB;
constexpr size_t SZ_WGU = (size_t)NGU * DM  , SZ_WDN = (size_t)DM * DFF * 2, SZ_SQ = (size_t)DM * DM * 2;
constexpr size_t WS_WGU = 2 * MiB;
constexpr size_t WS_WDN = WS_WGU + 8 * SZ_WGU;
constexpr size_t WS_WQKV = WS_WDN + 8 * SZ_WDN;
constexpr size_t WS_WO = WS_WQKV + (size_t)NQKV * DM * 2;
constexpr size_t WS_WCIN = WS_WO + SZ_SQ;
constexpr size_t WS_WCOUT = WS_WCIN + 3 * SZ_SQ;
constexpr size_t WS_WGATE = WS_WCOUT + SZ_SQ;
constexpr size_t WS_WUV = WS_WGATE + SZ_SQ;
constexpr size_t WS_WGOUT = WS_WUV + 2 * SZ_SQ;
constexpr size_t WS_WS = WS_WGOUT + SZ_SQ;
constexpr size_t SZ_ROWS = (size_t)(MT + 224) * DM * 2;
constexpr size_t WS_H = ((WS_WS + (size_t)GMG * GMC * GMC * 2 + MiB - 1) / MiB) * MiB;
constexpr size_t WS_T0 = WS_H + SZ_ROWS, WS_T1 = WS_T0 + SZ_ROWS, WS_T2 = WS_T1 + SZ_ROWS;
constexpr size_t WS_KB = WS_T2 + SZ_ROWS;
constexpr size_t WS_VB = WS_KB + (size_t)(MT + 224) * 256 * 2;
constexpr size_t WS_ACT = WS_VB + (size_t)(MT + 224) * 256 * 2;
constexpr size_t WS_D = WS_ACT + (size_t)(MT + 224) * DFF * 2;
constexpr size_t WS_HQ = WS_D + (size_t)(MT + 224) * DM * 4;
constexpr size_t WS_RS = WS_HQ + (size_t)(MT + 224) * DM;
constexpr size_t WS_CS = WS_RS + (size_t)(MT + 224) * 4;
constexpr size_t WS_P = WS_CS + (size_t)8 * NGU * 4;
constexpr size_t WS_X = WS_P + (size_t)4 * MS * 6144 * 4;
constexpr size_t WS_END = WS_X + (size_t)(MT + 224) * DM * 2;
constexpr int CW_BAR = 4096;

constexpr int RING_OFF = 0, RING_BYTES = 131072;
constexpr int LDSCTL_OFF = RING_BYTES, MISC_OFF = LDSCTL_OFF + 320;
constexpr int SC_OFF = MISC_OFF + 64, SC_BYTES = 6 * 512 * 4;
constexpr int LDS_BYTES = 147456;
static_assert(SC_OFF % 16 == 0 && SC_OFF + SC_BYTES <= LDS_BYTES, "scale table");

#define GAS __attribute__((address_space(1)))
#define LAS __attribute__((address_space(3)))
typedef unsigned short bf16;
typedef unsigned v4u __attribute__((ext_vector_type(4)));
typedef unsigned v2u __attribute__((ext_vector_type(2)));
typedef float f32x4 __attribute__((ext_vector_type(4)));
typedef float f32x16 __attribute__((ext_vector_type(16)));
typedef int i32x4 __attribute__((ext_vector_type(4)));
typedef int i32x16 __attribute__((ext_vector_type(16)));
typedef short bf16x8 __attribute__((ext_vector_type(8)));
typedef GAS unsigned gu32;
#define RLX_AGENT __ATOMIC_RELAXED, __HIP_MEMORY_SCOPE_AGENT
#define LDS_WAIT() asm volatile("s_waitcnt lgkmcnt(0)" ::: "memory")
#define VM_WAIT() asm volatile("s_waitcnt vmcnt(0)" ::: "memory")
using pg8::cvt_pk_bf16; using pg8::bf2f; using pg8::gelu_tanh_f; using pg8::gelu_tanh_pk; using pg8::f32x2_t; using pg8::fast_sigmoid; using pg8::silu_f;
__device__ __forceinline__ unsigned short f2bf(float f) { return (unsigned short)(cvt_pk_bf16(f, 0.f) & 0xffffu); }
#define XB_TMO      128
#define XB_XCNT(j)  (256  + 64 * (j))
#define XB_XSUB(j)  (1280 + 64 * (j))
#define XB_XGEN(j)  (2304 + 64 * (j))
#define XB_TOP      3328
#define XB_TOPGEN   3392
#define XCD_BAR_WORDS 3456
#define XB_SPIN_CAP (1u << 18)

__device__ __forceinline__ unsigned xb_ld(unsigned* p)              { return __hip_atomic_load(p, __ATOMIC_RELAXED, __HIP_MEMORY_SCOPE_AGENT); }
__device__ __forceinline__ unsigned xb_add(unsigned* p, unsigned v) { return __hip_atomic_fetch_add(p, v, __ATOMIC_RELAXED, __HIP_MEMORY_SCOPE_AGENT); }
__device__ __forceinline__ unsigned xb_xcc_id() { return (unsigned)__builtin_amdgcn_s_getreg((3 << 11) | 20) & 0xFu; }
#define XB_SPIN(cond, bar) do { unsigned _sp = 0; while (cond) { __builtin_amdgcn_s_sleep(1); \
    if ((++_sp & 255u) == 0u) { if (xb_ld(&(bar)[XB_TMO])) break; if (_sp > XB_SPIN_CAP) { atomicAdd(&(bar)[XB_TMO], 1u); break; } } } } while (0)

struct XcdBarrier {
    unsigned* bar; unsigned x;
    volatile LAS unsigned* st;
};

__device__ __forceinline__ XcdBarrier xcd_barrier_post(unsigned* bar, volatile LAS unsigned* st) {
    XcdBarrier b; b.bar = bar; b.x = xb_xcc_id(); b.st = st;
    if (threadIdx.x == 0) (void)xb_add(&bar[XB_XCNT(b.x)], 1u);
    return b;
}
__device__ __forceinline__ void xcd_barrier_complete(unsigned* bar, unsigned x, unsigned& nloc, unsigned& nx) {
    const unsigned G = gridDim.x * gridDim.y * gridDim.z;
    unsigned sum, cnt, mine, sp = 0u;
    for (;;) {
        sum = 0u; cnt = 0u; mine = 0u;
#pragma unroll
        for (unsigned j = 0; j < 16; ++j) { const unsigned c = xb_ld(&bar[XB_XCNT(j)]); sum += c; cnt += (c > 0u) ? 1u : 0u; mine = (j == x) ? c : mine; }
        if (sum == G) break;
        __builtin_amdgcn_s_sleep(1);
        if ((++sp & 255u) == 0u) { if (xb_ld(&bar[XB_TMO])) break; if (sp > XB_SPIN_CAP) { atomicAdd(&bar[XB_TMO], 1u); break; } }
    }
    nloc = mine > 0u ? mine : 1u; nx = cnt > 0u ? cnt : 1u;
}

__device__ __forceinline__ void xcd_barrier(const XcdBarrier& b) {
    asm volatile("s_waitcnt vmcnt(0)" ::: "memory");
    __builtin_amdgcn_s_waitcnt(0x0F70);
    __syncthreads();
    if (threadIdx.x == 0) {
        unsigned* bar = b.bar;
        __builtin_amdgcn_s_waitcnt(0);
        unsigned nloc = b.st[0], nx = b.st[1];
        if (nloc == 0u) { xcd_barrier_complete(bar, b.x, nloc, nx); b.st[0] = nloc; b.st[1] = nx; }
        const unsigned old = xb_add(&bar[XB_XSUB(b.x)], 1u);
        const unsigned gen = old / nloc;
        if (old + 1u == (gen + 1u) * nloc) {
            __builtin_amdgcn_fence(__ATOMIC_RELEASE, "agent");
            asm volatile("s_waitcnt vmcnt(0)" ::: "memory");
            const unsigned og = xb_add(&bar[XB_TOP], 1u);
            const unsigned tg = og / nx;
            if (og + 1u == (tg + 1u) * nx) xb_add(&bar[XB_TOPGEN], 1u);
            else XB_SPIN(xb_ld(&bar[XB_TOPGEN]) == tg, bar);
            __builtin_amdgcn_fence(__ATOMIC_ACQUIRE, "agent");
            xb_add(&bar[XB_XGEN(b.x)], 1u);
            asm volatile("s_waitcnt vmcnt(0)" ::: "memory");
        } else {
            XB_SPIN(xb_ld(&bar[XB_XGEN(b.x)]) == gen, bar);
            __builtin_amdgcn_fence(__ATOMIC_ACQUIRE, "agent");
            asm volatile("s_waitcnt vmcnt(0)" ::: "memory");
        }
    }
    __syncthreads();
}

struct Frame {
    LAS unsigned char* lds;
    volatile LAS unsigned* MISC;
    int tid, lane, wave;
    int vcu, G;
    unsigned char* ws;
    float* out;
};
__device__ __forceinline__ float wave_sum(float v) {
#pragma unroll
    for (int o = 1; o < 64; o <<= 1) v += __shfl_xor(v, o);
    return v;
}
__device__ __forceinline__ float wave_max(float v) {
#pragma unroll
    for (int o = 1; o < 64; o <<= 1) v = fmaxf(v, __shfl_xor(v, o));
    return v;
}

__device__ __forceinline__ void cvt_item(const float* W, int K, int N, bf16* WT, int k0, int n0, int drow, LAS float* scr, int lane) {
    f32x4 v[8];
#pragma unroll
    for (int i = 0; i < 8; ++i) { const int kk = 8 * i + (lane >> 3); v[i] = __builtin_nontemporal_load((const f32x4*)(W + (size_t)(k0 + kk) * N + n0 + 4 * (lane & 7))); }
#pragma unroll
    for (int i = 0; i < 8; ++i) { const int kk = 8 * i + (lane >> 3); LAS float* d = scr + kk * 33 + 4 * (lane & 7); d[0] = v[i].x; d[1] = v[i].y; d[2] = v[i].z; d[3] = v[i].w; }
    LDS_WAIT(); asm volatile("" ::: "memory");
    const int c = lane & 7;
#pragma unroll
    for (int j = 0; j < 4; ++j) { const int n = (lane >> 3) + 8 * j; const LAS float* s = scr + (8 * c) * 33 + n;
        v4u o; o.x = cvt_pk_bf16(s[0 * 33], s[1 * 33]); o.y = cvt_pk_bf16(s[2 * 33], s[3 * 33]); o.z = cvt_pk_bf16(s[4 * 33], s[5 * 33]); o.w = cvt_pk_bf16(s[6 * 33], s[7 * 33]);
        *(GAS v4u*)(WT + (size_t)(drow + n) * K + k0 + 8 * c) = o; }
    LDS_WAIT(); asm volatile("" ::: "memory");
}
__device__ __forceinline__ int map_plain(int n0) { return n0; }
__device__ __forceinline__ int map_gu(int n0) { const int half = n0 >= DFF ? 1 : 0, j = n0 - half * DFF; return 256 * (j >> 7) + 128 * half + (j & 127); }
__device__ __forceinline__ int map_cin(int n0) { if (n0 < DM) return 2 * DM + n0; const int q = (n0 - DM) >= DM ? 1 : 0, j = n0 - DM - q * DM; return 256 * (j >> 7) + 128 * q + (j & 127); }

struct In { const float* p[32]; };

enum CvtJob { CJ_GU = 0, CJ_DN = 8, CJ_QKV = 16, CJ_O, CJ_CIN, CJ_COUT, CJ_GATE, CJ_UV, CJ_GOUT };
__device__ __forceinline__ void cvt_job(Frame& F, const In& in, int job, int wi, int nw) {
    LAS float* scr = (LAS float*)(F.lds + RING_OFF + F.wave * 16384);
    const float* src; bf16* dst; int K, N, kind = 0;
    if (job < 8) { src = in.p[8] + (size_t)job * DM * NGU; dst = (bf16*)(F.ws + WS_WGU + job * SZ_WGU); K = DM; N = NGU; kind = 1; }
    else if (job < 16) { src = in.p[9] + (size_t)(job - 8) * DFF * DM; dst = (bf16*)(F.ws + WS_WDN + (job - 8) * SZ_WDN); K = DFF; N = DM; }
    else if (job == CJ_QKV) { src = in.p[10]; dst = (bf16*)(F.ws + WS_WQKV); K = DM; N = NQKV; }
    else if (job == CJ_O) { src = in.p[11]; dst = (bf16*)(F.ws + WS_WO); K = DM; N = DM; }
    else if (job == CJ_CIN) { src = in.p[13]; dst = (bf16*)(F.ws + WS_WCIN); K = DM; N = 3 * DM; kind = 2; }
    else if (job == CJ_COUT) { src = in.p[15]; dst = (bf16*)(F.ws + WS_WCOUT); K = DM; N = DM; }
    else if (job == CJ_GATE) { src = in.p[24]; dst = (bf16*)(F.ws + WS_WGATE); K = DM; N = DM; }
    else if (job == CJ_UV) { src = in.p[26]; dst = (bf16*)(F.ws + WS_WUV); K = DM; N = 2 * DM; }
    else { src = in.p[31]; dst = (bf16*)(F.ws + WS_WGOUT); K = DM; N = DM; }
    const int nblk = N / 32, nitems = (K / 64) * nblk;
    for (int it = wi; it < nitems; it += nw) { const int kb = it / nblk, nb = it - kb * nblk, n0 = 32 * nb;
        const int drow = kind == 1 ? map_gu(n0) : kind == 2 ? map_cin(n0) : n0;
        cvt_item(src, K, N, dst, 64 * kb, n0, drow, scr, F.lane); }
}
__device__ __forceinline__ void cvt_gu_strip(Frame& F, const float* W, signed char* Bq, float* cs, int n0) {
    LAS float* red = (LAS float*)(F.lds + RING_OFF);
    LAS unsigned* tile = (LAS unsigned*)(F.lds + RING_OFF + 2048);
    const int c = F.tid & 31, kg = F.tid >> 5, drow = map_gu(n0);
    float v[32][4]; float am = 0.f;
#pragma unroll
    for (int i = 0; i < 32; ++i)
#pragma unroll
        for (int e = 0; e < 4; ++e) v[i][e] = __builtin_nontemporal_load(W + (size_t)(64 * i + 4 * kg + e) * NGU + n0 + c);
#pragma unroll
    for (int i = 0; i < 32; ++i) am = fmaxf(am, fmaxf(fmaxf(fabsf(v[i][0]), fabsf(v[i][1])), fmaxf(fabsf(v[i][2]), fabsf(v[i][3]))));
    red[kg * 32 + c] = am;
    __syncthreads();
    float cm = 0.f;
#pragma unroll
    for (int k = 0; k < 16; ++k) cm = fmaxf(cm, red[k * 32 + c]);
    const float inv = cm > 0.f ? 127.f / cm : 0.f;
    if (kg == 0) cs[drow + c] = cm > 0.f ? cm * (1.f / 127.f) : 1.f;
#pragma unroll
    for (int i = 0; i < 32; ++i) {
        const float qa = fmaf(v[i][0], inv, 12582912.f), qb = fmaf(v[i][1], inv, 12582912.f), qc = fmaf(v[i][2], inv, 12582912.f), qd = fmaf(v[i][3], inv, 12582912.f);
        unsigned w = __builtin_amdgcn_perm(__builtin_bit_cast(unsigned, qb), __builtin_bit_cast(unsigned, qa), 0x0c0c0400u);
        w = __builtin_amdgcn_perm(__builtin_bit_cast(unsigned, qc), w, 0x0c040100u);
        w = __builtin_amdgcn_perm(__builtin_bit_cast(unsigned, qd), w, 0x04020100u);
        tile[c * 513 + 16 * i + kg] = w; }
    __syncthreads();
#pragma unroll
    for (int j = 0; j < 8; ++j) { const int qd = F.tid + 512 * j, row = qd >> 7, ch = qd & 127; const LAS unsigned* t = tile + row * 513 + 4 * ch;
        v4u w; w.x = t[0]; w.y = t[1]; w.z = t[2]; w.w = t[3];
        *(GAS v4u*)(Bq + (size_t)(drow + row) * DM + 16 * ch) = w; }
    __syncthreads();
}
__device__ __forceinline__ void cvt_gu_all(Frame& F, const In& in, int j0, int j1, int wg, int nwg) {
    constexpr int SPM = NGU / 32;
    for (int sid = j0 * SPM + wg; sid < j1 * SPM; sid += nwg) { const int j = sid / SPM, nb = sid - j * SPM;
        cvt_gu_strip(F, in.p[8] + (size_t)j * DM * NGU, (signed char*)(F.ws + WS_WGU + j * SZ_WGU), (float*)(F.ws + WS_CS) + (size_t)j * NGU, 32 * nb); }
}
__device__ __forceinline__ void p0_convert(Frame& F, const In& in) {
    const int gw = F.vcu * NWAVES + F.wave, NGW = F.G * NWAVES;
    cvt_gu_all(F, in, 0, 8, F.vcu, F.G);
    cvt_job(F, in, CJ_QKV, gw, NGW); cvt_job(F, in, CJ_GATE, gw, NGW); cvt_job(F, in, CJ_UV, gw, NGW); cvt_job(F, in, CJ_GOUT, gw, NGW);
    { const float* wsrc = in.p[29]; bf16* wd = (bf16*)(F.ws + WS_WS);
      for (int i = (F.vcu * NWAVES * 64 + F.tid); i < GMG * GMC * GMC; i += F.G * NWAVES * 64) { const int t = (i >> 7) & 127, s = i & 127; wd[i] = (s <= t) ? f2bf(wsrc[i]) : (bf16)0; } }
}

__device__ __forceinline__ float h2f(unsigned short b) { return (float)__builtin_bit_cast(_Float16, b); }
__device__ __forceinline__ unsigned pk_f16(float lo, float hi) { return (unsigned)__builtin_bit_cast(unsigned short, (_Float16)lo) | ((unsigned)__builtin_bit_cast(unsigned short, (_Float16)hi) << 16); }
template <bool HAS_D, bool XIN_F32 = false, bool XOUT_F32 = false>
__device__ __forceinline__ void resid_norm_rows(Frame& F, const float* xin_p, const float* xin_s, bf16* xb, float* xout, const bf16* Dm, float alpha, const float* g_post, const float* g_pre, bf16* H, unsigned* Hq = nullptr, float* rs = nullptr,
                                                const float* PS = nullptr, int nsl = 0, const bf16* gz = nullptr, const float* gb = nullptr, int row_begin = 0) {
    const int gw0 = F.vcu * NWAVES + F.wave, NGW = F.G * NWAVES;
    const bool spread = (row_begin == MP) && (NGW % MS == 0);
    const int gw = spread ? ((gw0 % (NGW / MS) == 0) ? gw0 / (NGW / MS) : MT) : gw0;
    for (int row0 = row_begin + gw; row0 < MT; row0 += 2 * NGW) {
        const int row1 = row0 + NGW; const bool two = row1 < MT;
        const int rr[2] = {row0, two ? row1 : row0};
        f32x4 xv[2][8]; v2u dw[2][8];
#pragma unroll
        for (int k = 0; k < 2; ++k) { const int row = rr[k];
            if (XIN_F32) { const float* xr = (row < MP) ? xin_p + (size_t)row * DM : xin_s + (size_t)(row - MP) * DM;
#pragma unroll
                for (int j = 0; j < 8; ++j) xv[k][j] = ((const GAS f32x4*)xr)[F.lane + 64 * j];
            } else {
#pragma unroll
                for (int j = 0; j < 8; ++j) { const v2u w = ((const GAS v2u*)(xb + (size_t)row * DM))[F.lane + 64 * j];
                    xv[k][j].x = h2f((bf16)(w.x & 0xffffu)); xv[k][j].y = h2f((bf16)(w.x >> 16)); xv[k][j].z = h2f((bf16)(w.y & 0xffffu)); xv[k][j].w = h2f((bf16)(w.y >> 16)); } }
            if (HAS_D) {
#pragma unroll
                for (int j = 0; j < 8; ++j) dw[k][j] = ((const GAS v2u*)(Dm + (size_t)row * DM))[F.lane + 64 * j]; } }
#pragma unroll
        for (int k = 0; k < 2; ++k) { const int row = rr[k]; if (k == 1 && !two) break;
            if (HAS_D) {
                f32x4 dv[8]; float ss = 0.f;
                if (PS != nullptr && row >= MP) {
#pragma unroll
                    for (int j = 0; j < 8; ++j) { f32x4 a = (f32x4){0.f, 0.f, 0.f, 0.f};
                        for (int sl = 0; sl < nsl; ++sl) a = a + ((const GAS f32x4*)(PS + ((size_t)sl * MS + (row - MP)) * DM))[F.lane + 64 * j];
                        if (gz != nullptr) { const f32x4 bb = ((const GAS f32x4*)gb)[F.lane + 64 * j]; const v2u zw = ((const GAS v2u*)(gz + (size_t)row * DM))[F.lane + 64 * j];
                            a.x = bf2f((bf16)(zw.x & 0xffffu)) * fast_sigmoid(a.x + bb.x); a.y = bf2f((bf16)(zw.x >> 16)) * fast_sigmoid(a.y + bb.y);
                            a.z = bf2f((bf16)(zw.y & 0xffffu)) * fast_sigmoid(a.z + bb.z); a.w = bf2f((bf16)(zw.y >> 16)) * fast_sigmoid(a.w + bb.w); }
                        dv[j] = a; ss += (a.x * a.x + a.y * a.y) + (a.z * a.z + a.w * a.w); }
                } else {
#pragma unroll
                for (int j = 0; j < 8; ++j) { const v2u w = dw[k][j];
                    dv[j].x = bf2f((bf16)(w.x & 0xffffu)); dv[j].y = bf2f((bf16)(w.x >> 16)); dv[j].z = bf2f((bf16)(w.y & 0xffffu)); dv[j].w = bf2f((bf16)(w.y >> 16));
                    ss += (dv[j].x * dv[j].x + dv[j].y * dv[j].y) + (dv[j].z * dv[j].z + dv[j].w * dv[j].w); }
                }
                f32x4 gpo[8];
#pragma unroll
                for (int j = 0; j < 8; ++j) gpo[j] = ((const GAS f32x4*)g_post)[F.lane + 64 * j];
                const float rstd = alpha * __builtin_amdgcn_rsqf(wave_sum(ss) * (1.f / DM) + EPS);
#pragma unroll
                for (int j = 0; j < 8; ++j) { const f32x4 g = gpo[j]; xv[k][j] = xv[k][j] + dv[j] * g * rstd; }
            }
            if (XOUT_F32) {
#pragma unroll
                for (int j = 0; j < 8; ++j) ((GAS f32x4*)(xout + (size_t)row * DM))[F.lane + 64 * j] = xv[k][j];
            } else {
#pragma unroll
                for (int j = 0; j < 8; ++j) { v2u w; w.x = pk_f16(xv[k][j].x, xv[k][j].y); w.y = pk_f16(xv[k][j].z, xv[k][j].w); ((GAS v2u*)(xb + (size_t)row * DM))[F.lane + 64 * j] = w;
                    xv[k][j].x = h2f((bf16)(w.x & 0xffffu)); xv[k][j].y = h2f((bf16)(w.x >> 16)); xv[k][j].z = h2f((bf16)(w.y & 0xffffu)); xv[k][j].w = h2f((bf16)(w.y >> 16)); }
            }
            if (g_pre) {
                f32x4 gpr[8];
#pragma unroll
                for (int j = 0; j < 8; ++j) gpr[j] = ((const GAS f32x4*)g_pre)[F.lane + 64 * j];
                float ss = 0.f;
#pragma unroll
                for (int j = 0; j < 8; ++j) ss += (xv[k][j].x * xv[k][j].x + xv[k][j].y * xv[k][j].y) + (xv[k][j].z * xv[k][j].z + xv[k][j].w * xv[k][j].w);
                const float rstd = __builtin_amdgcn_rsqf(wave_sum(ss) * (1.f / DM) + EPS);
                if (Hq == nullptr) {
#pragma unroll
                    for (int j = 0; j < 8; ++j) { const f32x4 g = gpr[j]; const f32x4 o = xv[k][j] * g * rstd;
                        v2u w; w.x = cvt_pk_bf16(o.x, o.y); w.y = cvt_pk_bf16(o.z, o.w); ((GAS v2u*)(H + (size_t)row * DM))[F.lane + 64 * j] = w; }
                } else {
                    float am = 0.f;
#pragma unroll
                    for (int j = 0; j < 8; ++j) { const f32x4 g = gpr[j]; xv[k][j] = xv[k][j] * g * rstd;
                        am = fmaxf(am, fmaxf(fmaxf(fabsf(xv[k][j].x), fabsf(xv[k][j].y)), fmaxf(fabsf(xv[k][j].z), fabsf(xv[k][j].w)))); }
                    am = wave_max(am); const float inv = am > 0.f ? 127.f / am : 0.f;
                    if (F.lane == 0) rs[row] = am > 0.f ? am * (1.f / 127.f) : 1.f;
#pragma unroll
                    for (int j = 0; j < 8; ++j) { const int q0 = (int)rintf(xv[k][j].x * inv), q1 = (int)rintf(xv[k][j].y * inv), q2 = (int)rintf(xv[k][j].z * inv), q3 = (int)rintf(xv[k][j].w * inv);
                        ((GAS unsigned*)(Hq + (size_t)row * (DM / 4)))[F.lane + 64 * j] = (unsigned)(q0 & 0xff) | ((unsigned)(q1 & 0xff) << 8) | ((unsigned)(q2 & 0xff) << 16) | ((unsigned)(q3 & 0xff) << 24); }
                }
            }
        }
    }
}

#define DPPF(old_, src_, ctrl_, rmask_) __builtin_bit_cast(float, __builtin_amdgcn_update_dpp(__builtin_bit_cast(int, (float)(old_)), __builtin_bit_cast(int, (float)(src_)), (ctrl_), (rmask_), 0xf, false))
__device__ __forceinline__ float wave_sum_dpp(float v) {
    v += DPPF(0.f, v, 0xB1, 0xf); v += DPPF(0.f, v, 0x4E, 0xf); v += DPPF(0.f, v, 0x141, 0xf); v += DPPF(0.f, v, 0x140, 0xf);
    v += DPPF(0.f, v, 0x142, 0xa); v += DPPF(0.f, v, 0x143, 0xc);
    return __builtin_bit_cast(float, __builtin_amdgcn_readlane(__builtin_bit_cast(int, v), 63));
}
__device__ __forceinline__ float wave_max_dpp(float v) {
    v = fmaxf(v, DPPF(0.f, v, 0xB1, 0xf)); v = fmaxf(v, DPPF(0.f, v, 0x4E, 0xf)); v = fmaxf(v, DPPF(0.f, v, 0x141, 0xf)); v = fmaxf(v, DPPF(0.f, v, 0x140, 0xf));
    v = fmaxf(v, DPPF(0.f, v, 0x142, 0xa)); v = fmaxf(v, DPPF(0.f, v, 0x143, 0xc));
    return __builtin_bit_cast(float, __builtin_amdgcn_readlane(__builtin_bit_cast(int, v), 63));
}
template <bool XOUT_F32>
__device__ __forceinline__ void resid_norm_sample(Frame& F, bf16* xb, float* xout, float alpha, const float* g_post, const float* g_pre, bf16* H, unsigned* Hq, float* rs, const float* PS, const bf16* gz, const float* gb) {
    const int gw0 = F.vcu * NWAVES + F.wave, NGW = F.G * NWAVES, lane = F.lane;
    const bool spread = (NGW % MS == 0);
    const int sidx = spread ? ((gw0 % (NGW / MS) == 0) ? gw0 / (NGW / MS) : MS) : gw0;
    if (sidx >= MS) return;
    const int row = MP + sidx;
    f32x4 dv[8]; v2u xw[8];
    {   f32x4 ps[4][8];
#pragma unroll
        for (int sl = 0; sl < 4; ++sl)
#pragma unroll
            for (int j = 0; j < 8; ++j) ps[sl][j] = ((const GAS f32x4*)(PS + ((size_t)sl * MS + sidx) * DM))[lane + 64 * j];
#pragma unroll
        for (int j = 0; j < 8; ++j) xw[j] = ((const GAS v2u*)(xb + (size_t)row * DM))[lane + 64 * j];
#pragma unroll
        for (int j = 0; j < 8; ++j) dv[j] = (ps[0][j] + ps[1][j]) + (ps[2][j] + ps[3][j]); }
    if (gz != nullptr) {
        f32x4 bb[8]; v2u zw[8];
#pragma unroll
        for (int j = 0; j < 8; ++j) { bb[j] = ((const GAS f32x4*)gb)[lane + 64 * j]; zw[j] = ((const GAS v2u*)(gz + (size_t)row * DM))[lane + 64 * j]; }
#pragma unroll
        for (int j = 0; j < 8; ++j) { f32x4 a = dv[j]; const v2u z = zw[j];
            a.x = bf2f((bf16)(z.x & 0xffffu)) * fast_sigmoid(a.x + bb[j].x); a.y = bf2f((bf16)(z.x >> 16)) * fast_sigmoid(a.y + bb[j].y);
            a.z = bf2f((bf16)(z.y & 0xffffu)) * fast_sigmoid(a.z + bb[j].z); a.w = bf2f((bf16)(z.y >> 16)) * fast_sigmoid(a.w + bb[j].w); dv[j] = a; } }
    float ss = 0.f;
#pragma unroll
    for (int j = 0; j < 8; ++j) ss += (dv[j].x * dv[j].x + dv[j].y * dv[j].y) + (dv[j].z * dv[j].z + dv[j].w * dv[j].w);
    f32x4 xv[8];
    {   f32x4 gpo[8];
#pragma unroll
        for (int j = 0; j < 8; ++j) gpo[j] = ((const GAS f32x4*)g_post)[lane + 64 * j];
        const float rstd = alpha * __builtin_amdgcn_rsqf(wave_sum_dpp(ss) * (1.f / DM) + EPS);
#pragma unroll
        for (int j = 0; j < 8; ++j) { const v2u w = xw[j]; f32x4 x0; x0.x = h2f((bf16)(w.x & 0xffffu)); x0.y = h2f((bf16)(w.x >> 16)); x0.z = h2f((bf16)(w.y & 0xffffu)); x0.w = h2f((bf16)(w.y >> 16));
            xv[j] = x0 + dv[j] * gpo[j] * rstd; } }
    f32x4 gpr[8];
    if (g_pre) {
#pragma unroll
        for (int j = 0; j < 8; ++j) gpr[j] = ((const GAS f32x4*)g_pre)[lane + 64 * j]; }
    if (XOUT_F32) {
#pragma unroll
        for (int j = 0; j < 8; ++j) ((GAS f32x4*)(xout + (size_t)row * DM))[lane + 64 * j] = xv[j];
    } else {
#pragma unroll
        for (int j = 0; j < 8; ++j) { v2u w; w.x = pk_f16(xv[j].x, xv[j].y); w.y = pk_f16(xv[j].z, xv[j].w); ((GAS v2u*)(xb + (size_t)row * DM))[lane + 64 * j] = w; } }
    if (g_pre) {
        float s2 = 0.f;
#pragma unroll
        for (int j = 0; j < 8; ++j) s2 += (xv[j].x * xv[j].x + xv[j].y * xv[j].y) + (xv[j].z * xv[j].z + xv[j].w * xv[j].w);
        const float rstd2 = __builtin_amdgcn_rsqf(wave_sum_dpp(s2) * (1.f / DM) + EPS);
        if (Hq == nullptr) {
#pragma unroll
            for (int j = 0; j < 8; ++j) { const f32x4 o = xv[j] * gpr[j] * rstd2; v2u w; w.x = cvt_pk_bf16(o.x, o.y); w.y = cvt_pk_bf16(o.z, o.w); ((GAS v2u*)(H + (size_t)row * DM))[lane + 64 * j] = w; }
        } else {
            float am = 0.f;
#pragma unroll
            for (int j = 0; j < 8; ++j) { xv[j] = xv[j] * gpr[j] * rstd2; am = fmaxf(am, fmaxf(fmaxf(fabsf(xv[j].x), fabsf(xv[j].y)), fmaxf(fabsf(xv[j].z), fabsf(xv[j].w)))); }
            am = wave_max_dpp(am); const float inv = am > 0.f ? 127.f / am : 0.f;
            if (lane == 0) rs[row] = am > 0.f ? am * (1.f / 127.f) : 1.f;
#pragma unroll
            for (int j = 0; j < 8; ++j) { const int q0 = (int)rintf(xv[j].x * inv), q1 = (int)rintf(xv[j].y * inv), q2 = (int)rintf(xv[j].z * inv), q3 = (int)rintf(xv[j].w * inv);
                ((GAS unsigned*)(Hq + (size_t)row * (DM / 4)))[lane + 64 * j] = (unsigned)(q0 & 0xff) | ((unsigned)(q1 & 0xff) << 8) | ((unsigned)(q2 & 0xff) << 16) | ((unsigned)(q3 & 0xff) << 24); }
        }
    }
}
template <bool XOUT_F32>
__device__ __forceinline__ void resid_norm_sample_wg(Frame& F, bf16* xb, float* xout, float alpha, const float* g_post, const float* g_pre, bf16* H, unsigned* Hq, float* rs, const float* PS, const bf16* gz, const float* gb) {
    if (F.G % MS != 0) { resid_norm_sample<XOUT_F32>(F, xb, xout, alpha, g_post, g_pre, H, Hq, rs, PS, gz, gb); return; }
    const int per = F.G / MS;
    if (F.vcu % per != 0) return;
    const int sidx = F.vcu / per, row = MP + sidx, t = F.tid;
    LAS float* red = (LAS float*)(F.lds + RING_OFF);
    f32x4 ps[4];
#pragma unroll
    for (int sl = 0; sl < 4; ++sl) ps[sl] = ((const GAS f32x4*)(PS + ((size_t)sl * MS + sidx) * DM))[t];
    const v2u xw = ((const GAS v2u*)(xb + (size_t)row * DM))[t];
    const f32x4 gpo = ((const GAS f32x4*)g_post)[t];
    f32x4 gpr = (f32x4){0.f, 0.f, 0.f, 0.f}; if (g_pre) gpr = ((const GAS f32x4*)g_pre)[t];
    f32x4 bb = (f32x4){0.f, 0.f, 0.f, 0.f}; v2u zw = (v2u){0u, 0u};
    if (gz != nullptr) { bb = ((const GAS f32x4*)gb)[t]; zw = ((const GAS v2u*)(gz + (size_t)row * DM))[t]; }
    f32x4 dv = (ps[0] + ps[1]) + (ps[2] + ps[3]);
    if (gz != nullptr) { dv.x = bf2f((bf16)(zw.x & 0xffffu)) * fast_sigmoid(dv.x + bb.x); dv.y = bf2f((bf16)(zw.x >> 16)) * fast_sigmoid(dv.y + bb.y);
        dv.z = bf2f((bf16)(zw.y & 0xffffu)) * fast_sigmoid(dv.z + bb.z); dv.w = bf2f((bf16)(zw.y >> 16)) * fast_sigmoid(dv.w + bb.w); }
    { const float w = wave_sum_dpp((dv.x * dv.x + dv.y * dv.y) + (dv.z * dv.z + dv.w * dv.w)); if (F.lane == 0) red[F.wave] = w; }
    __syncthreads();
    float ss = 0.f;
#pragma unroll
    for (int w = 0; w < 8; ++w) ss += red[w];
    const float rstd = alpha * __builtin_amdgcn_rsqf(ss * (1.f / DM) + EPS);
    f32x4 x0; x0.x = h2f((bf16)(xw.x & 0xffffu)); x0.y = h2f((bf16)(xw.x >> 16)); x0.z = h2f((bf16)(xw.y & 0xffffu)); x0.w = h2f((bf16)(xw.y >> 16));
    f32x4 xv = x0 + dv * gpo * rstd;
    if (XOUT_F32) ((GAS f32x4*)(xout + (size_t)row * DM))[t] = xv;
    else { v2u w; w.x = pk_f16(xv.x, xv.y); w.y = pk_f16(xv.z, xv.w); ((GAS v2u*)(xb + (size_t)row * DM))[t] = w; }
    if (g_pre) {
        { const float w = wave_sum_dpp((xv.x * xv.x + xv.y * xv.y) + (xv.z * xv.z + xv.w * xv.w)); if (F.lane == 0) red[8 + F.wave] = w; }
        __syncthreads();
        float s2 = 0.f;
#pragma unroll
        for (int w = 0; w < 8; ++w) s2 += red[8 + w];
        const float rstd2 = __builtin_amdgcn_rsqf(s2 * (1.f / DM) + EPS);
        xv = xv * gpr * rstd2;
        if (Hq == nullptr) { v2u w; w.x = cvt_pk_bf16(xv.x, xv.y); w.y = cvt_pk_bf16(xv.z, xv.w); ((GAS v2u*)(H + (size_t)row * DM))[t] = w; }
        else {
            { const float w = wave_max_dpp(fmaxf(fmaxf(fabsf(xv.x), fabsf(xv.y)), fmaxf(fabsf(xv.z), fabsf(xv.w)))); if (F.lane == 0) red[16 + F.wave] = w; }
            __syncthreads();
            float am = 0.f;
#pragma unroll
            for (int w = 0; w < 8; ++w) am = fmaxf(am, red[16 + w]);
            const float inv = am > 0.f ? 127.f / am : 0.f;
            if (t == 0) rs[row] = am > 0.f ? am * (1.f / 127.f) : 1.f;
            const int q0 = (int)rintf(xv.x * inv), q1 = (int)rintf(xv.y * inv), q2 = (int)rintf(xv.z * inv), q3 = (int)rintf(xv.w * inv);
            ((GAS unsigned*)(Hq + (size_t)row * (DM / 4)))[t] = (unsigned)(q0 & 0xff) | ((unsigned)(q1 & 0xff) << 8) | ((unsigned)(q2 & 0xff) << 16) | ((unsigned)(q3 & 0xff) << 24);
        }
    }
    __syncthreads();
}
template <bool XOUT_F32, bool HAS_D = true>
__device__ __forceinline__ void resid_norm_fast(Frame& F, bf16* xb, float* xout, const bf16* Dm, float alpha, const float* g_post, const float* g_pre, bf16* H, unsigned* Hq, float* rs) {
    typedef float f32x2 __attribute__((ext_vector_type(2)));
    typedef _Float16 f16x2 __attribute__((ext_vector_type(2)));
    const int gw = F.vcu * NWAVES + F.wave, NGW = F.G * NWAVES, lane = F.lane;
    f32x2 gp[4][4], gn[4][4];
    if (HAS_D) {
#pragma unroll
    for (int j = 0; j < 4; ++j) { const f32x4 a = ((const GAS f32x4*)g_post)[2 * (lane + 64 * j)], b = ((const GAS f32x4*)g_post)[2 * (lane + 64 * j) + 1];
        gp[j][0] = (f32x2){a.x, a.y}; gp[j][1] = (f32x2){a.z, a.w}; gp[j][2] = (f32x2){b.x, b.y}; gp[j][3] = (f32x2){b.z, b.w}; } }
    const float* xin = (const float*)Dm;
    if (g_pre) {
#pragma unroll
        for (int j = 0; j < 4; ++j) { const f32x4 a = ((const GAS f32x4*)g_pre)[2 * (lane + 64 * j)], b = ((const GAS f32x4*)g_pre)[2 * (lane + 64 * j) + 1];
            gn[j][0] = (f32x2){a.x, a.y}; gn[j][1] = (f32x2){a.z, a.w}; gn[j][2] = (f32x2){b.x, b.y}; gn[j][3] = (f32x2){b.z, b.w}; } }
    v4u xr[4], dr[4];
    const bool xaff = (F.G == 256) && (NGW == 2048);
    const int xcd_ = F.vcu >> 5, lw_ = (F.vcu & 31) * NWAVES + F.wave;
    const int rstep = xaff ? 256 : NGW;
    int row = xaff ? 256 * (8 * (xcd_ >> 1) + 4 * (xcd_ & 1)) + lw_ : gw;
    const int rend = xaff ? row + 1024 : MP;
    if (row < rend) {
#pragma unroll
        for (int j = 0; j < 4; ++j) { if (HAS_D) { xr[j] = ((const GAS v4u*)(xb + (size_t)row * DM))[lane + 64 * j]; dr[j] = ((const GAS v4u*)(Dm + (size_t)row * DM))[lane + 64 * j]; }
            else { xr[j] = ((const GAS v4u*)(xin + (size_t)row * DM))[2 * (lane + 64 * j)]; dr[j] = ((const GAS v4u*)(xin + (size_t)row * DM))[2 * (lane + 64 * j) + 1]; } } }
    for (; row < rend; row += rstep) {
        v4u xc[4], dc[4];
#pragma unroll
        for (int j = 0; j < 4; ++j) { xc[j] = xr[j]; dc[j] = dr[j]; }
        const int nrow = row + rstep;
        if (nrow < rend) {
#pragma unroll
            for (int j = 0; j < 4; ++j) { if (HAS_D) { xr[j] = ((const GAS v4u*)(xb + (size_t)nrow * DM))[lane + 64 * j]; dr[j] = ((const GAS v4u*)(Dm + (size_t)nrow * DM))[lane + 64 * j]; }
                else { xr[j] = ((const GAS v4u*)(xin + (size_t)nrow * DM))[2 * (lane + 64 * j)]; dr[j] = ((const GAS v4u*)(xin + (size_t)nrow * DM))[2 * (lane + 64 * j) + 1]; } } }
        f32x2 xv[4][4]; f32x2 ss2 = (f32x2){0.f, 0.f};
        if (HAS_D) {
        f32x2 dv[4][4]; f32x2 ssv = (f32x2){0.f, 0.f};
#pragma unroll
        for (int j = 0; j < 4; ++j)
#pragma unroll
            for (int e = 0; e < 4; ++e) { const unsigned w = dc[j][e]; dv[j][e] = (f32x2){__builtin_bit_cast(float, w << 16), __builtin_bit_cast(float, w & 0xffff0000u)}; ssv = dv[j][e] * dv[j][e] + ssv; }
        const float rstd = alpha * __builtin_amdgcn_rsqf(wave_sum_dpp(ssv.x + ssv.y) * (1.f / DM) + EPS);
#pragma unroll
        for (int j = 0; j < 4; ++j)
#pragma unroll
            for (int e = 0; e < 4; ++e) { const unsigned xw = xc[j][e]; const f16x2 hx = __builtin_bit_cast(f16x2, xw); const f32x2 x0 = (f32x2){(float)hx.x, (float)hx.y};
                xv[j][e] = (dv[j][e] * gp[j][e]) * rstd + x0; ss2 = xv[j][e] * xv[j][e] + ss2; }
        } else {
#pragma unroll
        for (int j = 0; j < 4; ++j) { const unsigned a0 = xc[j].x, a1 = xc[j].y, a2 = xc[j].z, a3 = xc[j].w, b0 = dc[j].x, b1 = dc[j].y, b2 = dc[j].z, b3 = dc[j].w;
            xv[j][0] = (f32x2){__builtin_bit_cast(float, a0), __builtin_bit_cast(float, a1)}; xv[j][1] = (f32x2){__builtin_bit_cast(float, a2), __builtin_bit_cast(float, a3)};
            xv[j][2] = (f32x2){__builtin_bit_cast(float, b0), __builtin_bit_cast(float, b1)}; xv[j][3] = (f32x2){__builtin_bit_cast(float, b2), __builtin_bit_cast(float, b3)};
#pragma unroll
            for (int e = 0; e < 4; ++e) ss2 = xv[j][e] * xv[j][e] + ss2; }
        }
        if (XOUT_F32) {
#pragma unroll
            for (int j = 0; j < 4; ++j) { ((GAS f32x4*)(xout + (size_t)row * DM))[2 * (lane + 64 * j)] = (f32x4){xv[j][0].x, xv[j][0].y, xv[j][1].x, xv[j][1].y};
                ((GAS f32x4*)(xout + (size_t)row * DM))[2 * (lane + 64 * j) + 1] = (f32x4){xv[j][2].x, xv[j][2].y, xv[j][3].x, xv[j][3].y}; }
        } else {
#pragma unroll
            for (int j = 0; j < 4; ++j) { v4u w;
#pragma unroll
                for (int e = 0; e < 4; ++e) w[e] = __builtin_bit_cast(unsigned, __builtin_convertvector(xv[j][e], f16x2));
                ((GAS v4u*)(xb + (size_t)row * DM))[lane + 64 * j] = w; } }
        if (g_pre) {
            const float rstd2 = __builtin_amdgcn_rsqf(wave_sum_dpp(ss2.x + ss2.y) * (1.f / DM) + EPS);
            if (Hq == nullptr) {
#pragma unroll
                for (int j = 0; j < 4; ++j) { v4u w;
#pragma unroll
                    for (int e = 0; e < 4; ++e) { const f32x2 o = (xv[j][e] * gn[j][e]) * rstd2; w[e] = cvt_pk_bf16(o.x, o.y); }
                    ((GAS v4u*)(H + (size_t)row * DM))[lane + 64 * j] = w; }
            } else {
                float am = 0.f;
#pragma unroll
                for (int j = 0; j < 4; ++j)
#pragma unroll
                    for (int e = 0; e < 4; ++e) { xv[j][e] = (xv[j][e] * gn[j][e]) * rstd2; am = fmaxf(am, fmaxf(fabsf(xv[j][e].x), fabsf(xv[j][e].y))); }
                am = wave_max_dpp(am); const float inv = am > 0.f ? 127.f / am : 0.f;
                if (lane == 0) rs[row] = am > 0.f ? am * (1.f / 127.f) : 1.f;
#pragma unroll
                for (int j = 0; j < 4; ++j) { unsigned wq[2];
#pragma unroll
                    for (int h = 0; h < 2; ++h) { const float xa = xv[j][2 * h].x, xb_ = xv[j][2 * h].y, xc_ = xv[j][2 * h + 1].x, xd = xv[j][2 * h + 1].y;
                        const float qa = fmaf(xa, inv, 12582912.f), qb = fmaf(xb_, inv, 12582912.f), qc = fmaf(xc_, inv, 12582912.f), qd = fmaf(xd, inv, 12582912.f);
                        unsigned w = __builtin_amdgcn_perm(__builtin_bit_cast(unsigned, qb), __builtin_bit_cast(unsigned, qa), 0x0c0c0400u);
                        w = __builtin_amdgcn_perm(__builtin_bit_cast(unsigned, qc), w, 0x0c040100u);
                        w = __builtin_amdgcn_perm(__builtin_bit_cast(unsigned, qd), w, 0x04020100u);
                        wq[h] = w; }
                    v2u w2; w2.x = wq[0]; w2.y = wq[1];
                    ((GAS v2u*)((GAS unsigned char*)Hq + (size_t)row * DM))[lane + 64 * j] = w2; }
            }
        }
    }
}

template <int NB, class RowB, class Epi>
__device__ __forceinline__ void skinny_gemm(Frame& F, const bf16* A, int lda, const bf16* Bt, int K, int nunits, int ufirst, int ustride, const RowB& rowb, const Epi& epi) {
    LAS float* red = (LAS float*)(F.lds + RING_OFF);
    const int r = F.lane & 31, h = F.lane >> 5, kper = K / 8, kbeg = F.wave * kper, nit = kper / 64;
    for (int u = ufirst; u < nunits; u += ustride) {
        f32x16 acc[NB];
#pragma unroll
        for (int b = 0; b < NB; ++b)
#pragma unroll
            for (int e = 0; e < 16; ++e) acc[b][e] = 0.f;
        const bf16* ap = A + (size_t)r * lda + kbeg + 32 * h;
        const bf16* bp[NB];
#pragma unroll
        for (int b = 0; b < NB; ++b) bp[b] = Bt + (size_t)(rowb(u, b) + r) * K + kbeg + 32 * h;
        bf16x8 a4[2][4], b4[2][NB][4];
#pragma unroll
        for (int i = 0; i < 4; ++i) a4[0][i] = *(const GAS bf16x8*)(ap + 8 * i);
#pragma unroll
        for (int b = 0; b < NB; ++b)
#pragma unroll
            for (int i = 0; i < 4; ++i) b4[0][b][i] = *(const GAS bf16x8*)(bp[b] + 8 * i);
        for (int it = 0; it < nit; it += 2) {
            { const int kk = (it + 1 < nit ? it + 1 : it) * 64;
#pragma unroll
              for (int i = 0; i < 4; ++i) a4[1][i] = *(const GAS bf16x8*)(ap + kk + 8 * i);
#pragma unroll
              for (int b = 0; b < NB; ++b)
#pragma unroll
                  for (int i = 0; i < 4; ++i) b4[1][b][i] = *(const GAS bf16x8*)(bp[b] + kk + 8 * i); }
#pragma unroll
            for (int b = 0; b < NB; ++b)
#pragma unroll
                for (int i = 0; i < 4; ++i) acc[b] = __builtin_amdgcn_mfma_f32_32x32x16_bf16(a4[0][i], b4[0][b][i], acc[b], 0, 0, 0);
            if (it + 1 < nit) {
                { const int kk = (it + 2 < nit ? it + 2 : it + 1) * 64;
#pragma unroll
                  for (int i = 0; i < 4; ++i) a4[0][i] = *(const GAS bf16x8*)(ap + kk + 8 * i);
#pragma unroll
                  for (int b = 0; b < NB; ++b)
#pragma unroll
                      for (int i = 0; i < 4; ++i) b4[0][b][i] = *(const GAS bf16x8*)(bp[b] + kk + 8 * i); }
#pragma unroll
                for (int b = 0; b < NB; ++b)
#pragma unroll
                    for (int i = 0; i < 4; ++i) acc[b] = __builtin_amdgcn_mfma_f32_32x32x16_bf16(a4[1][i], b4[1][b][i], acc[b], 0, 0, 0);
            }
        }
#pragma unroll
        for (int b = 0; b < NB; ++b)
#pragma unroll
            for (int e = 0; e < 16; ++e) red[((F.wave * NB + b) * 32 + ((e & 3) + 8 * (e >> 2) + 4 * h)) * 32 + r] = acc[b][e];
        __syncthreads();
#pragma unroll
        for (int q = 0; q < 2; ++q) { const int e = F.tid + 512 * q, row = e >> 5, col = e & 31; float v[NB];
#pragma unroll
            for (int b = 0; b < NB; ++b) { float s = 0.f;
#pragma unroll
                for (int w = 0; w < 8; ++w) s += red[((w * NB + b) * 32 + row) * 32 + col];
                v[b] = s; }
            epi(u, row, col, v); }
        __syncthreads();
    }
}

template <class Epi>
__device__ __forceinline__ void skinny_gemm_i8(Frame& F, const signed char* A, const float* rs, const signed char* Bq, const float* cs, int nunits, int ufirst, int ustride, const Epi& epi) {
    LAS int* red = (LAS int*)(F.lds + RING_OFF);
    const int r = F.lane & 31, h = F.lane >> 5, kbeg = F.wave * (DM / 8);
    for (int u = ufirst; u < nunits; u += ustride) {
        i32x16 acc[2];
#pragma unroll
        for (int b = 0; b < 2; ++b)
#pragma unroll
            for (int e = 0; e < 16; ++e) acc[b][e] = 0;
        const int rb0 = 256 * (u >> 2) + 32 * (u & 3);
        const signed char* ap = A + (size_t)r * DM + kbeg + 64 * h;
        const signed char* bp0 = Bq + (size_t)(rb0 + r) * DM + kbeg + 64 * h;
        const signed char* bp1 = bp0 + (size_t)128 * DM;
        i32x4 a4[2][4], b4[2][2][4];
#pragma unroll
        for (int ch = 0; ch < 2; ++ch)
#pragma unroll
            for (int i = 0; i < 4; ++i) { a4[ch][i] = *(const GAS i32x4*)(ap + 128 * ch + 16 * i); b4[ch][0][i] = *(const GAS i32x4*)(bp0 + 128 * ch + 16 * i); b4[ch][1][i] = *(const GAS i32x4*)(bp1 + 128 * ch + 16 * i); }
#pragma unroll
        for (int ch = 0; ch < 2; ++ch)
#pragma unroll
            for (int b = 0; b < 2; ++b)
#pragma unroll
                for (int i = 0; i < 4; ++i) acc[b] = __builtin_amdgcn_mfma_i32_32x32x32_i8(a4[ch][i], b4[ch][b][i], acc[b], 0, 0, 0);
#pragma unroll
        for (int b = 0; b < 2; ++b)
#pragma unroll
            for (int e = 0; e < 16; ++e) red[((F.wave * 2 + b) * 32 + ((e & 3) + 8 * (e >> 2) + 4 * h)) * 32 + r] = acc[b][e];
        __syncthreads();
#pragma unroll
        for (int q = 0; q < 2; ++q) { const int e = F.tid + 512 * q, row = e >> 5, col = e & 31; float v[2]; const float rsc = rs[row];
#pragma unroll
            for (int b = 0; b < 2; ++b) { int sm = 0;
#pragma unroll
                for (int w = 0; w < 8; ++w) sm += red[((w * 2 + b) * 32 + row) * 32 + col];
                v[b] = (float)sm * rsc * cs[rb0 + 128 * b + col]; }
            epi(u, row, col, v); }
        __syncthreads();
    }
}

template <int NB, class RowB, class ColMap>
__device__ __forceinline__ void skinny_ks(Frame& F, const bf16* A, int lda, const bf16* Bt, int K, int ncg, int nsl, const RowB& rowb, const ColMap& colmap, float* P, int ldp) {
    LAS float* red = (LAS float*)(F.lds + RING_OFF);
    const int fr = F.lane & 15, fq = F.lane >> 4, cps = (K / 64) / nsl;
    for (int u = F.vcu; u < ncg * nsl; u += F.G) { const int cg = u % ncg, sl = u / ncg;
        const int c0 = sl * cps + (cps * F.wave) / 8, c1 = sl * cps + (cps * (F.wave + 1)) / 8, nc = c1 - c0;
        f32x4 acc[NB][2][2];
#pragma unroll
        for (int b = 0; b < NB; ++b)
#pragma unroll
            for (int bi = 0; bi < 2; ++bi)
#pragma unroll
                for (int bj = 0; bj < 2; ++bj) acc[b][bi][bj] = (f32x4){0.f, 0.f, 0.f, 0.f};
        const bf16* ap = A + (size_t)fr * lda + 64 * c0 + 8 * fq;
        bf16x8 a4[3][2][2], b4[3][NB][2][2];
#pragma unroll
        for (int c = 0; c < 3; ++c) { if (c < nc) {
#pragma unroll
            for (int bi = 0; bi < 2; ++bi)
#pragma unroll
                for (int ks = 0; ks < 2; ++ks) a4[c][bi][ks] = *(const GAS bf16x8*)(ap + (size_t)(16 * bi) * lda + 64 * c + 32 * ks);
#pragma unroll
            for (int b = 0; b < NB; ++b) { const bf16* bp = Bt + (size_t)(rowb(cg, b) + fr) * K + 64 * c0 + 8 * fq;
#pragma unroll
                for (int bj = 0; bj < 2; ++bj)
#pragma unroll
                    for (int ks = 0; ks < 2; ++ks) b4[c][b][bj][ks] = *(const GAS bf16x8*)(bp + (size_t)(16 * bj) * K + 64 * c + 32 * ks); } } }
#pragma unroll
        for (int c = 0; c < 3; ++c) { if (c < nc) {
#pragma unroll
            for (int b = 0; b < NB; ++b)
#pragma unroll
                for (int ks = 0; ks < 2; ++ks)
#pragma unroll
                    for (int bi = 0; bi < 2; ++bi)
#pragma unroll
                        for (int bj = 0; bj < 2; ++bj) acc[b][bi][bj] = __builtin_amdgcn_mfma_f32_16x16x32_bf16(a4[c][bi][ks], b4[c][b][bj][ks], acc[b][bi][bj], 0, 0, 0); } }
#pragma unroll
        for (int b = 0; b < NB; ++b)
#pragma unroll
            for (int bi = 0; bi < 2; ++bi)
#pragma unroll
                for (int bj = 0; bj < 2; ++bj)
#pragma unroll
                    for (int e = 0; e < 4; ++e) red[((F.wave * NB + b) * 32 + (16 * bi + 4 * fq + e)) * 32 + 16 * bj + fr] = acc[b][bi][bj][e];
        __syncthreads();
#pragma unroll
        for (int q = 0; q < 2; ++q) { const int e = F.tid + 512 * q, row = e >> 5, col = e & 31;
#pragma unroll
            for (int b = 0; b < NB; ++b) { float sm = 0.f;
#pragma unroll
                for (int w = 0; w < 8; ++w) sm += red[((w * NB + b) * 32 + row) * 32 + col];
                P[((size_t)sl * MS + row) * ldp + colmap(cg, b) + col] = sm; } }
        __syncthreads();
    }
}

constexpr int KS_STRIDE = 72, VT_STRIDE = 260;
constexpr int ATT_KS_OFF = 0, ATT_VT_OFF = 256 * KS_STRIDE * 2;
constexpr float LOG2E = 1.4426950408889634f;

__device__ __forceinline__ void unpack8(const v4u w, float (&o)[8]) { const unsigned ww[4] = {w.x, w.y, w.z, w.w};
#pragma unroll
    for (int e = 0; e < 4; ++e) { o[2 * e] = bf2f((bf16)(ww[e] & 0xffffu)); o[2 * e + 1] = bf2f((bf16)(ww[e] >> 16)); } }
__device__ __forceinline__ void attn_prompt_unit(Frame& F, int b, int kvh, int blk, const bf16* Q, const bf16* Kb, const bf16* Vb, bf16* O, const float* sinks) {
    LAS bf16* Ks = (LAS bf16*)(F.lds + RING_OFF + ATT_KS_OFF);
    LAS bf16* Vt = (LAS bf16*)(F.lds + RING_OFF + ATT_VT_OFF);
    const int lane = F.lane, r = lane & 31, h = lane >> 5;
    const int head = kvh * 8 + F.wave;
    bf16x8 qfa[4][4];
#pragma unroll
    for (int a = 0; a < 4; ++a)
#pragma unroll
        for (int c = 0; c < 4; ++c) qfa[a][c] = *(const GAS bf16x8*)(Q + (size_t)(b * SEQ + blk * 128 + 32 * a + r) * DM + head * 64 + 16 * c + 8 * h);
    const int kpos0 = blk * 128 - 128;
#pragma unroll
    for (int i = 0; i < 4; ++i) { const int idx = F.tid + 512 * i, s = idx >> 3, c = idx & 7; const int kp = kpos0 + s;
        v4u kv = (v4u){0u, 0u, 0u, 0u}, vv = (v4u){0u, 0u, 0u, 0u};
        if (kp >= 0) { const size_t off = (size_t)(b * SEQ + kp) * 256 + kvh * 64 + 8 * c; kv = *(const GAS v4u*)(Kb + off); vv = *(const GAS v4u*)(Vb + off); }
        *(LAS v4u*)(Ks + s * KS_STRIDE + 8 * c) = kv;
        const unsigned w[4] = {vv.x, vv.y, vv.z, vv.w};
#pragma unroll
        for (int e = 0; e < 4; ++e) { Vt[(8 * c + 2 * e) * VT_STRIDE + s] = (bf16)(w[e] & 0xffffu); Vt[(8 * c + 2 * e + 1) * VT_STRIDE + s] = (bf16)(w[e] >> 16); } }
    __syncthreads();
    const float sink2 = sinks[head] * LOG2E;
    const float sc2 = ATTN_SCALE * LOG2E;
#pragma unroll
    for (int a = 0; a < 4; ++a) {
        const int qrow = b * SEQ + blk * 128 + 32 * a + r;
        bf16x8 qf[4];
#pragma unroll
        for (int c = 0; c < 4; ++c) qf[c] = qfa[a][c];
        f32x16 st[5];
#pragma unroll
        for (int j = 0; j < 5; ++j) {
#pragma unroll
            for (int e = 0; e < 16; ++e) st[j][e] = 0.f;
#pragma unroll
            for (int c = 0; c < 4; ++c) { const bf16x8 kf = *(const LAS bf16x8*)(Ks + (32 * (a + j) + r) * KS_STRIDE + 16 * c + 8 * h);
                st[j] = __builtin_amdgcn_mfma_f32_32x32x16_bf16(kf, qf[c], st[j], 0, 0, 0); } }
        float mx = -3.0e38f;
#pragma unroll
        for (int j = 0; j < 5; ++j) { const bool tile_ok = (blk > 0) || (a + j >= 4);
#pragma unroll
            for (int e = 0; e < 16; ++e) { const int kr = (e & 3) + 8 * (e >> 2) + 4 * h;
                float t = st[j][e];
                if (j == 0) t = (kr > r) ? t : -3.0e38f;
                if (j == 4) t = (kr <= r) ? t : -3.0e38f;
                if (!tile_ok) t = -3.0e38f;
                st[j][e] = t; mx = fmaxf(mx, t); } }
        mx = fmaxf(mx, __shfl_xor(mx, 32)); mx = fmaxf(mx * sc2, sink2);
        float sum = 0.f;
#pragma unroll
        for (int j = 0; j < 5; ++j)
#pragma unroll
            for (int e = 0; e < 16; ++e) { const float p = __builtin_amdgcn_exp2f(fmaf(st[j][e], sc2, -mx)); st[j][e] = p; sum += p; }
        sum += __shfl_xor(sum, 32); sum += __builtin_amdgcn_exp2f(sink2 - mx);
        const float inv = 1.0f / sum;
        f32x16 o[2];
#pragma unroll
        for (int d = 0; d < 2; ++d)
#pragma unroll
            for (int e = 0; e < 16; ++e) o[d][e] = 0.f;
#pragma unroll
        for (int j = 0; j < 5; ++j)
#pragma unroll
            for (int ks = 0; ks < 2; ++ks) {
                bf16x8 pf; { v4u w; w.x = cvt_pk_bf16(st[j][8 * ks + 0], st[j][8 * ks + 1]); w.y = cvt_pk_bf16(st[j][8 * ks + 2], st[j][8 * ks + 3]); w.z = cvt_pk_bf16(st[j][8 * ks + 4], st[j][8 * ks + 5]); w.w = cvt_pk_bf16(st[j][8 * ks + 6], st[j][8 * ks + 7]); pf = __builtin_bit_cast(bf16x8, w); }
#pragma unroll
                for (int d = 0; d < 2; ++d) { const LAS bf16* vp = Vt + (32 * d + r) * VT_STRIDE + 32 * (a + j) + 16 * ks + 4 * h;
                    const v2u lo = *(const LAS v2u*)vp, hi = *(const LAS v2u*)(vp + 8);
                    const v4u vw = (v4u){lo.x, lo.y, hi.x, hi.y};
                    o[d] = __builtin_amdgcn_mfma_f32_32x32x16_bf16(__builtin_bit_cast(bf16x8, vw), pf, o[d], 0, 0, 0); } }
#pragma unroll
        for (int d = 0; d < 2; ++d)
#pragma unroll
            for (int g = 0; g < 4; ++g) { v2u w; w.x = cvt_pk_bf16(o[d][4 * g] * inv, o[d][4 * g + 1] * inv); w.y = cvt_pk_bf16(o[d][4 * g + 2] * inv, o[d][4 * g + 3] * inv);
                *(GAS v2u*)(O + (size_t)qrow * DM + head * 64 + 32 * d + 8 * g + 4 * h) = w; }
    }
    __syncthreads();
}

constexpr int SK_STRIDE = 65;
constexpr int ATS_K_OFF = 0, ATS_V_OFF = 128 * SK_STRIDE * 4, ATS_Q_OFF = ATS_V_OFF + 128 * 64 * 4, ATS_P_OFF = ATS_Q_OFF + 8 * 64 * 4, ATS_END = ATS_P_OFF + 8 * 128 * 4;
static_assert(ATS_END <= RING_BYTES, "sample attention LDS");
__device__ __forceinline__ void attn_sample_unit(Frame& F, int b, int kvh, const bf16* Q, const bf16* Kb, const bf16* Vb, bf16* O, const float* sinks, const float* cache_k, const float* cache_v, float* outk, float* outv) {
    LAS float* Kc = (LAS float*)(F.lds + RING_OFF + ATS_K_OFF);
    LAS float* Vc = (LAS float*)(F.lds + RING_OFF + ATS_V_OFF);
    LAS float* qs = (LAS float*)(F.lds + RING_OFF + ATS_Q_OFF) + F.wave * 64;
    LAS float* ps = (LAS float*)(F.lds + RING_OFF + ATS_P_OFF) + F.wave * 128;
    const int lane = F.lane, head = kvh * 8 + F.wave;
    const size_t qrow = (size_t)(MP + b);
    f32x4 kr[4], vr[4];
#pragma unroll
    for (int i = 0; i < 4; ++i) { const int idx = F.tid + 512 * i, j = idx >> 4, c = idx & 15;
        if (j < 127) { const size_t ii = ((size_t)(b * 128 + j + 1) * NKV + kvh) * 64 + 4 * c; kr[i] = *(const GAS f32x4*)(cache_k + ii); vr[i] = *(const GAS f32x4*)(cache_v + ii); }
        else { const v2u kw = *(const GAS v2u*)(Kb + qrow * 256 + kvh * 64 + 4 * c), vw = *(const GAS v2u*)(Vb + qrow * 256 + kvh * 64 + 4 * c);
            kr[i] = (f32x4){bf2f((bf16)(kw.x & 0xffffu)), bf2f((bf16)(kw.x >> 16)), bf2f((bf16)(kw.y & 0xffffu)), bf2f((bf16)(kw.y >> 16))};
            vr[i] = (f32x4){bf2f((bf16)(vw.x & 0xffffu)), bf2f((bf16)(vw.x >> 16)), bf2f((bf16)(vw.y & 0xffffu)), bf2f((bf16)(vw.y >> 16))}; } }
    qs[lane] = bf2f(Q[qrow * DM + head * 64 + lane]);
#pragma unroll
    for (int i = 0; i < 4; ++i) { const int idx = F.tid + 512 * i, j = idx >> 4, c = idx & 15;
        LAS float* kd = Kc + j * SK_STRIDE + 4 * c; kd[0] = kr[i].x; kd[1] = kr[i].y; kd[2] = kr[i].z; kd[3] = kr[i].w;
        *(LAS f32x4*)(Vc + j * 64 + 4 * c) = vr[i];
        const size_t oo = ((size_t)(b * 128 + j) * NKV + kvh) * 64 + 4 * c;
        *(GAS f32x4*)(outk + oo) = kr[i]; *(GAS f32x4*)(outv + oo) = vr[i]; }
    __syncthreads();
    float sc[2];
#pragma unroll
    for (int t = 0; t < 2; ++t) { const LAS float* kp = Kc + (lane + 64 * t) * SK_STRIDE; float s0 = 0.f, s1 = 0.f;
#pragma unroll
        for (int d = 0; d < 64; d += 2) { s0 += kp[d] * qs[d]; s1 += kp[d + 1] * qs[d + 1]; }
        sc[t] = (s0 + s1) * ATTN_SCALE; }
    const float sink = sinks[head];
    const float mx = fmaxf(wave_max(fmaxf(sc[0], sc[1])), sink);
    const float p0 = __expf(sc[0] - mx), p1 = __expf(sc[1] - mx);
    const float den = wave_sum(p0 + p1) + __expf(sink - mx);
    ps[lane] = p0; ps[lane + 64] = p1;
    LDS_WAIT(); asm volatile("" ::: "memory");
    float o0 = 0.f, o1 = 0.f;
#pragma unroll 16
    for (int j = 0; j < 128; j += 2) { o0 += ps[j] * Vc[j * 64 + lane]; o1 += ps[j + 1] * Vc[(j + 1) * 64 + lane]; }
    O[qrow * DM + head * 64 + lane] = f2bf((o0 + o1) / den);
    LDS_WAIT(); asm volatile("" ::: "memory");
}

__device__ __forceinline__ void attn_phase_all(Frame& F, const In& in, const bf16* Q, const bf16* Kb, const bf16* Vb, bf16* O) {
    const float* sinks = in.p[12];
    for (int u = F.vcu; u < NB_P * NKV * 32; u += F.G) { const int b = u >> 7, kvh = (u >> 5) & 3, blk = u & 31;
        attn_prompt_unit(F, b, kvh, blk, Q, Kb, Vb, O, sinks);
        if (blk == 31) {
            v4u kq[2], vq[2];
#pragma unroll
            for (int it = 0; it < 2; ++it) { const int gi = F.tid + 512 * it, s = gi >> 3, c = gi & 7; const size_t src = (size_t)(b * SEQ + SEQ - 128 + s) * 256 + kvh * 64 + 8 * c;
                kq[it] = *(const GAS v4u*)(Kb + src); vq[it] = *(const GAS v4u*)(Vb + src); }
#pragma unroll
            for (int it = 0; it < 2; ++it) { const int gi = F.tid + 512 * it, s = gi >> 3, c = gi & 7; const size_t dst = ((size_t)(b * 128 + s) * NKV + kvh) * 64 + 8 * c;
                float kf[8], vf[8]; unpack8(kq[it], kf); unpack8(vq[it], vf);
                *(GAS f32x4*)(F.out + O_KP + dst) = (f32x4){kf[0], kf[1], kf[2], kf[3]}; *(GAS f32x4*)(F.out + O_KP + dst + 4) = (f32x4){kf[4], kf[5], kf[6], kf[7]};
                *(GAS f32x4*)(F.out + O_VP + dst) = (f32x4){vf[0], vf[1], vf[2], vf[3]}; *(GAS f32x4*)(F.out + O_VP + dst + 4) = (f32x4){vf[4], vf[5], vf[6], vf[7]}; } } }
    for (int u = F.vcu; u < MS * NKV; u += F.G) { __syncthreads(); attn_sample_unit(F, u >> 2, u & 3, Q, Kb, Vb, O, sinks, in.p[2], in.p[3], F.out + O_KS, F.out + O_VS); }
}

__device__ __forceinline__ void conv_pass(Frame& F, const In& in, const bf16* Y, const bf16* BG, bf16* A2, const float* PS, int nsl) {
    const int gw = F.vcu * NWAVES + F.wave, NGW = F.G * NWAVES;
    const float* cw = in.p[14];
    const float* st = in.p[4];
    f32x4 cwr[3][4][2];
#pragma unroll
    for (int k = 0; k < 3; ++k)
#pragma unroll
        for (int j = 0; j < 4; ++j)
#pragma unroll
            for (int hh = 0; hh < 2; ++hh) cwr[k][j][hh] = *(const GAS f32x4*)(cw + (size_t)k * DM + 8 * (F.lane + 64 * j) + 4 * hh);
    for (int row = gw; row < MP; row += NGW) {
        v4u ry2[4], rbg[4], ry1[4], ry0[4];
        const int t = row & (SEQ - 1);
#pragma unroll
        for (int j = 0; j < 4; ++j) { const int c0 = 8 * (F.lane + 64 * j); const v4u z = (v4u){0u, 0u, 0u, 0u};
            ry2[j] = *(const GAS v4u*)(Y + (size_t)row * DM + c0); rbg[j] = *(const GAS v4u*)(BG + (size_t)row * DM + c0);
            ry1[j] = (t >= 1) ? *(const GAS v4u*)(Y + (size_t)(row - 1) * DM + c0) : z; ry0[j] = (t >= 2) ? *(const GAS v4u*)(Y + (size_t)(row - 2) * DM + c0) : z; }
#pragma unroll
        for (int j = 0; j < 4; ++j) { const int c0 = 8 * (F.lane + 64 * j);
            float y0[8], y1[8], y2[8], bg[8];
            unpack8(ry2[j], y2); unpack8(rbg[j], bg); unpack8(ry1[j], y1); unpack8(ry0[j], y0);
            if (t >= SEQ - 2) { float* o = F.out + O_CP + ((size_t)(row >> 12) * 2 + (t - (SEQ - 2))) * DM + c0;
#pragma unroll
                for (int e = 0; e < 8; ++e) o[e] = y2[e]; }
            float r[8];
#pragma unroll
            for (int hh = 0; hh < 2; ++hh) { const f32x4 a = cwr[0][j][hh], b = cwr[1][j][hh], d = cwr[2][j][hh];
                r[4 * hh + 0] = bg[4 * hh + 0] * (a.x * y0[4 * hh + 0] + b.x * y1[4 * hh + 0] + d.x * y2[4 * hh + 0]);
                r[4 * hh + 1] = bg[4 * hh + 1] * (a.y * y0[4 * hh + 1] + b.y * y1[4 * hh + 1] + d.y * y2[4 * hh + 1]);
                r[4 * hh + 2] = bg[4 * hh + 2] * (a.z * y0[4 * hh + 2] + b.z * y1[4 * hh + 2] + d.z * y2[4 * hh + 2]);
                r[4 * hh + 3] = bg[4 * hh + 3] * (a.w * y0[4 * hh + 3] + b.w * y1[4 * hh + 3] + d.w * y2[4 * hh + 3]); }
            v4u w; w.x = cvt_pk_bf16(r[0], r[1]); w.y = cvt_pk_bf16(r[2], r[3]); w.z = cvt_pk_bf16(r[4], r[5]); w.w = cvt_pk_bf16(r[6], r[7]);
            *(GAS v4u*)(A2 + (size_t)row * DM + c0) = w; }
    }
    { const bool spread = (NGW % MS == 0); const int b = spread ? ((gw % (NGW / MS) == 0) ? gw / (NGW / MS) : MS) : gw;
      if (b < MS) { const int row = MP + b;
#pragma unroll
        for (int j = 0; j < 4; ++j) { const int c0 = 8 * (F.lane + 64 * j);
            f32x4 pv[4][3][2]; f32x4 s0[2], s1[2];
#pragma unroll
            for (int sl = 0; sl < 4; ++sl)
#pragma unroll
                for (int k = 0; k < 3; ++k)
#pragma unroll
                    for (int hh = 0; hh < 2; ++hh) pv[sl][k][hh] = (sl < nsl) ? *(const GAS f32x4*)(PS + ((size_t)sl * MS + b) * (3 * DM) + (size_t)k * DM + c0 + 4 * hh) : (f32x4){0.f, 0.f, 0.f, 0.f};
#pragma unroll
            for (int hh = 0; hh < 2; ++hh) { s0[hh] = *(const GAS f32x4*)(st + ((size_t)b * 2 + 0) * DM + c0 + 4 * hh); s1[hh] = *(const GAS f32x4*)(st + ((size_t)b * 2 + 1) * DM + c0 + 4 * hh); }
            float* o = F.out + O_CS + (size_t)b * 2 * DM + c0; v4u w;
#pragma unroll
            for (int hh = 0; hh < 2; ++hh) { const f32x4 cg = (pv[0][0][hh] + pv[1][0][hh]) + (pv[2][0][hh] + pv[3][0][hh]), hv = (pv[0][1][hh] + pv[1][1][hh]) + (pv[2][1][hh] + pv[3][1][hh]), bgv = (pv[0][2][hh] + pv[1][2][hh]) + (pv[2][2][hh] + pv[3][2][hh]);
                const f32x4 y2 = cg * hv, y1 = s1[hh], y0 = s0[hh];
                *(GAS f32x4*)(o + 4 * hh) = y1; *(GAS f32x4*)(o + DM + 4 * hh) = y2;
                const f32x4 r = bgv * (cwr[0][j][hh] * y0 + cwr[1][j][hh] * y1 + cwr[2][j][hh] * y2);
                w[2 * hh] = cvt_pk_bf16(r.x, r.y); w[2 * hh + 1] = cvt_pk_bf16(r.z, r.w); }
            *(GAS v4u*)(A2 + (size_t)row * DM + c0) = w; } } }
}

__device__ __forceinline__ void sincos_cw(float x, float& s, float& c) {
    const float kf = rintf(x * 0.63661977236758134f); const int k = (int)kf;
    float r = fmaf(-kf, 1.5707962513e+00f, x); r = fmaf(-kf, 7.5497894159e-08f, r); r = fmaf(-kf, 5.3903029534e-15f, r);
    const float r2 = r * r;
    const float sp = r + r * r2 * (-1.6666654611e-1f + r2 * (8.3321608736e-3f + r2 * (-1.9515295891e-4f)));
    const float cp = 1.0f - 0.5f * r2 + r2 * r2 * (4.166664568298827e-2f + r2 * (-1.388731625493765e-3f + r2 * 2.443315711809948e-5f));
    const int q = k & 3;
    s = (q == 0) ? sp : (q == 1) ? cp : (q == 2) ? -sp : -cp;
    c = (q == 0) ? cp : (q == 1) ? -sp : (q == 2) ? -cp : sp;
}
constexpr int S5_BU_STRIDE = 132, S5_H_STRIDE = 136;
constexpr int S5_BU_BYTES = 16 * S5_BU_STRIDE * 4, S5_H_BYTES = 16 * S5_H_STRIDE * 2, S5_WAVE_BYTES = S5_BU_BYTES + S5_H_BYTES;
constexpr int S5_PAR_OFF = 8 * S5_WAVE_BYTES;
constexpr int S5_AB = S5_PAR_OFF, S5_BB = S5_AB + 1024, S5_E = S5_BB + 8192, S5_DD = S5_E + 4096, S5_END = S5_DD + 64;
static_assert(S5_END <= RING_BYTES, "S5 LDS");

template <int XM>
__device__ __forceinline__ void s5_unit(Frame& F, const In& in, int b, int g, const bf16* H, bf16* Z) {
    LAS float* AB = (LAS float*)(F.lds + RING_OFF + S5_AB);
    LAS float* BB = (LAS float*)(F.lds + RING_OFF + S5_BB);
    LAS float* EE = (LAS float*)(F.lds + RING_OFF + S5_E);
    LAS float* DD = (LAS float*)(F.lds + RING_OFF + S5_DD);
    LAS float* Bu = (LAS float*)(F.lds + RING_OFF + F.wave * S5_WAVE_BYTES);
    LAS bf16* Hs = (LAS bf16*)(F.lds + RING_OFF + F.wave * S5_WAVE_BYTES + S5_BU_BYTES);
    const int lane = F.lane, tid = F.tid;
    const float* a_re = in.p[16]; const float* a_im = in.p[17]; const float* log_dt = in.p[18]; const float* b_re = in.p[19]; const float* b_im = in.p[20];
    const float* c_re = in.p[21]; const float* c_im = in.p[22]; const float* d_skip = in.p[23];
    const int j16 = lane & 15, q = lane >> 4;
    f32x4 craw[4][2];
#pragma unroll
    for (int ks = 0; ks < 4; ++ks) { const int p0 = 16 * ks + 4 * q; craw[ks][0] = *(const GAS f32x4*)(c_re + ((size_t)g * SSG + j16) * SSP + p0); craw[ks][1] = *(const GAS f32x4*)(c_im + ((size_t)g * SSG + j16) * SSP + p0); }
    const int se0 = 16 * b + 2 * F.wave;
    v4u suw = (v4u){0u, 0u, 0u, 0u};
    if (j16 < 2 && q < 2) suw = *(const GAS v4u*)(H + (size_t)(MP + se0 + j16) * DM + g * SSG + 8 * q);
    float sh0r[2], sh0i[2];
#pragma unroll
    for (int t = 0; t < 2; ++t) { const size_t si = ((size_t)(se0 + t) * SSN + g) * SSP + lane; sh0r[t] = in.p[5][si]; sh0i[t] = in.p[6][si]; }
    __syncthreads();
    const float dt = __expf(log_dt[g]);
    {
        const int p = tid & 63; const float lr = a_re[g * SSP + p], li = a_im[g * SSP + p];
        const float mag = __expf(lr * dt); float sn, cs; sincos_cw(li * dt, sn, cs);
        const float abr = mag * cs, abi = mag * sn, den = lr * lr + li * li;
        const float kr = ((abr - 1.0f) * lr + abi * li) / den, ki = (abi * lr - (abr - 1.0f) * li) / den;
        if (tid < 64) { float pr = abr, pi = abi;
#pragma unroll
            for (int i = 0; i < 9; ++i) { const float nr = pr * pr - pi * pi, ni = 2.f * pr * pi; pr = nr; pi = ni; }
            AB[4 * p] = abr; AB[4 * p + 1] = abi; AB[4 * p + 2] = pr; AB[4 * p + 3] = pi; }
#pragma unroll
        for (int cc = 0; cc < 2; ++cc) { const int c = 2 * (tid >> 6) + cc; const float br = b_re[((size_t)g * SSP + p) * SSG + c], bi = b_im[((size_t)g * SSP + p) * SSG + c];
            BB[p * 16 + c] = kr * br - ki * bi; BB[1024 + p * 16 + c] = kr * bi + ki * br; }
        if (tid < 16) DD[tid] = d_skip[g * SSG + tid];
    }
    __syncthreads();
    bf16x8 bfrag[8];
#pragma unroll
    for (int ct = 0; ct < 8; ++ct) { v4u w;
        { const int comp = 16 * ct + j16; const LAS f32x4* src = (const LAS f32x4*)(BB + (comp & 1) * 1024 + (comp >> 1) * 16 + 8 * (q & 1));
            const f32x4 s0 = src[0], s1 = src[1];
            w.x = cvt_pk_bf16(s0.x, s0.y); w.y = cvt_pk_bf16(s0.z, s0.w); w.z = cvt_pk_bf16(s1.x, s1.y); w.w = cvt_pk_bf16(s1.z, s1.w); }
        bfrag[ct] = __builtin_bit_cast(bf16x8, w); }
    bf16x8 dfrag;
    { const float dv = DD[j16]; const unsigned db = (unsigned)f2bf(dv); v4u w = (v4u){0u, 0u, 0u, 0u}; const int e = j16 - 8 * (q & 1);
      if (e >= 0 && e < 8) { const unsigned val = (e & 1) ? (db << 16) : db; if ((e >> 1) == 0) w.x = val; else if ((e >> 1) == 1) w.y = val; else if ((e >> 1) == 2) w.z = val; else w.w = val; }
      dfrag = __builtin_bit_cast(bf16x8, w); }
    bf16x8 cfrag[4];
#pragma unroll
    for (int ks = 0; ks < 4; ++ks) { const f32x4 sr = craw[ks][0], si = craw[ks][1];
        v4u w; w.x = cvt_pk_bf16(sr.x, -si.x); w.y = cvt_pk_bf16(sr.y, -si.y); w.z = cvt_pk_bf16(sr.z, -si.z); w.w = cvt_pk_bf16(sr.w, -si.w);
        cfrag[ks] = __builtin_bit_cast(bf16x8, w); }
    typedef float f32x2 __attribute__((ext_vector_type(2)));
    const float ar = AB[4 * lane], ai = AB[4 * lane + 1];
    const f32x2 aa1 = (f32x2){ar, ar}, aa2 = (f32x2){-ai, ai};
    const size_t rowbase = (size_t)b * SEQ + (size_t)F.wave * 512;
    {   const int e0 = se0;
        const bf16x8 ufrag = __builtin_bit_cast(bf16x8, suw);
#pragma unroll
        for (int ct = 0; ct < 8; ++ct) { f32x4 acc = (f32x4){0.f, 0.f, 0.f, 0.f};
            acc = __builtin_amdgcn_mfma_f32_16x16x32_bf16(bfrag[ct], ufrag, acc, 0, 0, 0);
            *(LAS f32x4*)(Bu + j16 * S5_BU_STRIDE + 16 * ct + 4 * q) = acc; }
        LDS_WAIT(); asm volatile("" ::: "memory");
#pragma unroll
        for (int t = 0; t < 2; ++t) { const f32x2 bb = *(const LAS f32x2*)(Bu + t * S5_BU_STRIDE + 2 * lane);
            const size_t si = ((size_t)(e0 + t) * SSN + g) * SSP + lane;
            const float h0r = sh0r[t], h0i = sh0i[t];
            const float h1r = ar * h0r - ai * h0i + bb.x, h1i = ar * h0i + ai * h0r + bb.y;
            F.out[O_SRS + si] = h1r; F.out[O_SIS + si] = h1i;
            *(LAS unsigned*)(Hs + t * S5_H_STRIDE + 2 * lane) = cvt_pk_bf16(h1r, h1i); }
        LDS_WAIT(); asm volatile("" ::: "memory");
        f32x4 y = (f32x4){0.f, 0.f, 0.f, 0.f};
        y = __builtin_amdgcn_mfma_f32_16x16x32_bf16(dfrag, ufrag, y, 0, 0, 0);
#pragma unroll
        for (int ks = 0; ks < 4; ++ks) { const bf16x8 hf = *(const LAS bf16x8*)(Hs + j16 * S5_H_STRIDE + 32 * ks + 8 * q);
            y = __builtin_amdgcn_mfma_f32_16x16x32_bf16(cfrag[ks], hf, y, 0, 0, 0); }
        if (j16 < 2) {
            const float z0 = gelu_tanh_f(y[0]), z1 = gelu_tanh_f(y[1]), z2 = gelu_tanh_f(y[2]), z3 = gelu_tanh_f(y[3]);
            v2u zw; zw.x = cvt_pk_bf16(z0, z1); zw.y = cvt_pk_bf16(z2, z3);
            *(GAS v2u*)(Z + (size_t)(MP + e0 + j16) * DM + g * SSG + 4 * q) = zw; }
        LDS_WAIT(); asm volatile("" ::: "memory");
    }
    f32x2 hh = (f32x2){0.f, 0.f};
    for (int pass = 0; pass < (XM == 2 ? 1 : XM == 3 ? 0 : 2); ++pass) {
        if (pass == 1) {
            EE[F.wave * 128 + lane] = hh.x; EE[F.wave * 128 + 64 + lane] = hh.y;
            __syncthreads();
            const float a5r = AB[4 * lane + 2], a5i = AB[4 * lane + 3];
            float cr = 0.f, ci = 0.f;
            for (int w = 0; w < F.wave; ++w) { const float er = EE[w * 128 + lane], ei = EE[w * 128 + 64 + lane]; const float nr = a5r * cr - a5i * ci + er, ni = a5r * ci + a5i * cr + ei; cr = nr; ci = ni; }
            hh = (f32x2){cr, ci};
        }
        constexpr int PF = 8;
        v4u uring[PF];
        const bf16* ubase = H + (rowbase + 16 * (q >> 1) + j16) * DM + g * SSG + 8 * (q & 1);
#pragma unroll
        for (int k = 0; k < PF; ++k) uring[k] = *(const GAS v4u*)(ubase + (size_t)(32 * k) * DM);
        for (int dc0 = 0; dc0 < 16; dc0 += PF) {
#pragma unroll
        for (int k = 0; k < PF; ++k) {
            const int dc = dc0 + k;
            const v4u upair = uring[k];
            if (dc + PF < 16) uring[k] = *(const GAS v4u*)(ubase + (size_t)(32 * (dc + PF)) * DM);
#pragma unroll
        for (int half = 0; half < 2; ++half) {
            const int ch = 2 * dc + half;
            const size_t row0 = rowbase + 16 * ch;
            const bool mine = (q >> 1) == half;
            v4u uw; uw.x = mine ? upair.x : 0u; uw.y = mine ? upair.y : 0u; uw.z = mine ? upair.z : 0u; uw.w = mine ? upair.w : 0u;
            const bf16x8 ufrag = __builtin_bit_cast(bf16x8, uw);
            {   f32x4 acc8[8];
#pragma unroll
                for (int ct = 0; ct < 8; ++ct) acc8[ct] = __builtin_amdgcn_mfma_f32_16x16x32_bf16(bfrag[ct], ufrag, (f32x4){0.f, 0.f, 0.f, 0.f}, 0, 0, 0);
#pragma unroll
                for (int ct = 0; ct < 8; ++ct) *(LAS f32x4*)(Bu + j16 * S5_BU_STRIDE + 16 * ct + 4 * q) = acc8[ct]; }
            LDS_WAIT(); asm volatile("" ::: "memory");
            f32x2 bbv[16];
#pragma unroll
            for (int t = 0; t < 16; ++t) bbv[t] = *(const LAS f32x2*)(Bu + t * S5_BU_STRIDE + 2 * lane);
            LDS_WAIT(); asm volatile("" ::: "memory");
            if (pass == 0) {
#pragma unroll
                for (int t = 0; t < 16; ++t) { const f32x2 hsw = (f32x2){hh.y, hh.x}; hh = aa1 * hh + (aa2 * hsw + bbv[t]); }
            } else {
                unsigned hp[16];
#pragma unroll
                for (int t = 0; t < 16; ++t) { const f32x2 hsw = (f32x2){hh.y, hh.x}; hh = aa1 * hh + (aa2 * hsw + bbv[t]); hp[t] = cvt_pk_bf16(hh.x, hh.y); }
#pragma unroll
                for (int t = 0; t < 16; ++t) *(LAS unsigned*)(Hs + t * S5_H_STRIDE + 2 * lane) = hp[t];
                LDS_WAIT(); asm volatile("" ::: "memory");
                bf16x8 hf[4];
#pragma unroll
                for (int ks = 0; ks < 4; ++ks) hf[ks] = *(const LAS bf16x8*)(Hs + j16 * S5_H_STRIDE + 32 * ks + 8 * q);
                f32x4 y = __builtin_amdgcn_mfma_f32_16x16x32_bf16(dfrag, ufrag, (f32x4){0.f, 0.f, 0.f, 0.f}, 0, 0, 0);
                f32x4 y2 = __builtin_amdgcn_mfma_f32_16x16x32_bf16(cfrag[0], hf[0], (f32x4){0.f, 0.f, 0.f, 0.f}, 0, 0, 0);
                y = __builtin_amdgcn_mfma_f32_16x16x32_bf16(cfrag[1], hf[1], y, 0, 0, 0);
                y2 = __builtin_amdgcn_mfma_f32_16x16x32_bf16(cfrag[2], hf[2], y2, 0, 0, 0);
                y = __builtin_amdgcn_mfma_f32_16x16x32_bf16(cfrag[3], hf[3], y, 0, 0, 0);
                y = y + y2;
                const f32x2_t za = gelu_tanh_pk((f32x2_t){y.x, y.y}), zb = gelu_tanh_pk((f32x2_t){y.z, y.w});
                v2u zw; zw.x = cvt_pk_bf16(za.x, za.y); zw.y = cvt_pk_bf16(zb.x, zb.y);
                if (XM != 1) *(GAS v2u*)(Z + (row0 + j16) * DM + g * SSG + 4 * q) = zw; else if (zw.x == 0x12345678u && zw.y == 0x9abcdef0u) *(GAS v2u*)(Z + (row0 + j16) * DM + g * SSG + 4 * q) = zw;
            }
            LDS_WAIT(); asm volatile("" ::: "memory");
        }
        }
        }
    }
    if (XM < 2 && F.wave == 7) { F.out[O_SRP + ((size_t)b * SSN + g) * SSP + lane] = hh.x; F.out[O_SIP + ((size_t)b * SSN + g) * SSP + lane] = hh.y; }

}
#ifndef S5_XMODE
#define S5_XMODE 0
#endif
template <int XM = 0>
__device__ __forceinline__ void s5_phase(Frame& F, const In& in, const bf16* H, bf16* Z) {
    for (int u = F.vcu; u < NB_P * SSN; u += F.G) s5_unit<XM>(F, in, u >> 7, u & 127, H, Z);
    __syncthreads();
}

__device__ __forceinline__ void gm_ln_pass(Frame& F, const In& in, const bf16* U, const bf16* V, bf16* VN, bf16* A3, const float* PS, int nsl) {
    const int gw = F.vcu * NWAVES + F.wave, NGW = F.G * NWAVES;
    const float* lg = in.p[27]; const float* lb = in.p[28]; const float* w_s = in.p[29]; const float* b_s = in.p[30];
    float lgv[4][8], lbv[4][8];
#pragma unroll
    for (int j = 0; j < 4; ++j)
#pragma unroll
        for (int hh = 0; hh < 2; ++hh) { const int c = 8 * (F.lane + 64 * j) + 4 * hh; const f32x4 a = *(const GAS f32x4*)(lg + c), b = *(const GAS f32x4*)(lb + c);
            lgv[j][4 * hh] = a.x; lgv[j][4 * hh + 1] = a.y; lgv[j][4 * hh + 2] = a.z; lgv[j][4 * hh + 3] = a.w; lbv[j][4 * hh] = b.x; lbv[j][4 * hh + 1] = b.y; lbv[j][4 * hh + 2] = b.z; lbv[j][4 * hh + 3] = b.w; }
    {
        v4u nx[4]; int prow = gw;
        if (prow < MP) {
#pragma unroll
            for (int j = 0; j < 4; ++j) nx[j] = *(const GAS v4u*)(V + (size_t)prow * DM + 8 * (F.lane + 64 * j)); }
        for (; prow < MP; prow += NGW) {
            v4u cur[4];
#pragma unroll
            for (int j = 0; j < 4; ++j) cur[j] = nx[j];
            const int nrow = prow + NGW;
            if (nrow < MP) {
#pragma unroll
                for (int j = 0; j < 4; ++j) nx[j] = *(const GAS v4u*)(V + (size_t)nrow * DM + 8 * (F.lane + 64 * j)); }
            float v[4][8]; float s = 0.f;
#pragma unroll
            for (int j = 0; j < 4; ++j) { const unsigned ww[4] = {cur[j].x, cur[j].y, cur[j].z, cur[j].w};
#pragma unroll
                for (int e = 0; e < 4; ++e) { v[j][2 * e] = bf2f((bf16)(ww[e] & 0xffffu)); v[j][2 * e + 1] = bf2f((bf16)(ww[e] >> 16)); s += v[j][2 * e] + v[j][2 * e + 1]; } }
            const float mu = wave_sum_dpp(s) * (1.f / DM); float q = 0.f;
#pragma unroll
            for (int j = 0; j < 4; ++j)
#pragma unroll
                for (int e = 0; e < 8; ++e) { v[j][e] -= mu; q += v[j][e] * v[j][e]; }
            const float rstd = __builtin_amdgcn_rsqf(wave_sum_dpp(q) * (1.f / DM) + EPS);
#pragma unroll
            for (int j = 0; j < 4; ++j) { const int c0 = 8 * (F.lane + 64 * j); float o[8];
#pragma unroll
                for (int e = 0; e < 8; ++e) o[e] = v[j][e] * rstd * lgv[j][e] + lbv[j][e];
                v4u w; w.x = cvt_pk_bf16(o[0], o[1]); w.y = cvt_pk_bf16(o[2], o[3]); w.z = cvt_pk_bf16(o[4], o[5]); w.w = cvt_pk_bf16(o[6], o[7]); *(GAS v4u*)(VN + (size_t)prow * DM + c0) = w; }
        }
    }
    { const bool spread = (NGW % MS == 0); const int b = spread ? ((gw % (NGW / MS) == 0) ? gw / (NGW / MS) : MS) : gw;
      if (b < MS) { const int row = MP + b;
        f32x4 pu[2][4][2], pv[2][4][2]; float wv[4], bv[4];
#pragma unroll
        for (int sl = 0; sl < 2; ++sl)
#pragma unroll
            for (int j = 0; j < 4; ++j)
#pragma unroll
                for (int hh = 0; hh < 2; ++hh) { const float* pp = PS + ((size_t)sl * MS + b) * (2 * DM) + 8 * (F.lane + 64 * j) + 4 * hh; const f32x4 z = (f32x4){0.f, 0.f, 0.f, 0.f};
                    pu[sl][j][hh] = (sl < nsl) ? *(const GAS f32x4*)pp : z; pv[sl][j][hh] = (sl < nsl) ? *(const GAS f32x4*)(pp + DM) : z; }
#pragma unroll
        for (int j = 0; j < 4; ++j) { const int g = (8 * (F.lane + 64 * j)) >> 7; wv[j] = w_s[(size_t)g * GMC * GMC]; bv[j] = b_s[g * GMC]; }
        float v[4][8]; float s = 0.f;
#pragma unroll
        for (int j = 0; j < 4; ++j)
#pragma unroll
            for (int hh = 0; hh < 2; ++hh) { const f32x4 t = pv[0][j][hh] + pv[1][j][hh];
                v[j][4 * hh] = gelu_tanh_f(t.x); v[j][4 * hh + 1] = gelu_tanh_f(t.y); v[j][4 * hh + 2] = gelu_tanh_f(t.z); v[j][4 * hh + 3] = gelu_tanh_f(t.w);
                s += (v[j][4 * hh] + v[j][4 * hh + 1]) + (v[j][4 * hh + 2] + v[j][4 * hh + 3]); }
        const float mu = wave_sum(s) * (1.f / DM); float q = 0.f;
#pragma unroll
        for (int j = 0; j < 4; ++j)
#pragma unroll
            for (int e = 0; e < 8; ++e) { v[j][e] -= mu; q += v[j][e] * v[j][e]; }
        const float rstd = __builtin_amdgcn_rsqf(wave_sum(q) * (1.f / DM) + EPS);
#pragma unroll
        for (int j = 0; j < 4; ++j) { const int c0 = 8 * (F.lane + 64 * j); float o[8], r[8];
#pragma unroll
            for (int e = 0; e < 8; ++e) o[e] = v[j][e] * rstd * lgv[j][e] + lbv[j][e];
            float* go = F.out + O_GV + (size_t)b * DM + c0;
#pragma unroll
            for (int hh = 0; hh < 2; ++hh) { const f32x4 uv = pu[0][j][hh] + pu[1][j][hh];
                *(GAS f32x4*)(go + 4 * hh) = (f32x4){o[4 * hh], o[4 * hh + 1], o[4 * hh + 2], o[4 * hh + 3]};
                r[4 * hh] = gelu_tanh_f(uv.x) * (wv[j] * o[4 * hh] + bv[j]); r[4 * hh + 1] = gelu_tanh_f(uv.y) * (wv[j] * o[4 * hh + 1] + bv[j]);
                r[4 * hh + 2] = gelu_tanh_f(uv.z) * (wv[j] * o[4 * hh + 2] + bv[j]); r[4 * hh + 3] = gelu_tanh_f(uv.w) * (wv[j] * o[4 * hh + 3] + bv[j]); }
            v4u w; w.x = cvt_pk_bf16(r[0], r[1]); w.y = cvt_pk_bf16(r[2], r[3]); w.z = cvt_pk_bf16(r[4], r[5]); w.w = cvt_pk_bf16(r[6], r[7]); *(GAS v4u*)(A3 + (size_t)row * DM + c0) = w; }
      } }
}
constexpr int VNT_STRIDE = 136;
constexpr int SGW_OFF = 128 * VNT_STRIDE * 2, SGU_OFF = 2 * SGW_OFF;
static_assert(3 * SGW_OFF <= RING_BYTES, "SGU LDS");
__device__ __forceinline__ void sgu_phase(Frame& F, const In& in, const bf16* U, const bf16* VN, const bf16* WS, bf16* A3) {
    LAS bf16* VnT = (LAS bf16*)(F.lds + RING_OFF);
    LAS bf16* Wl = (LAS bf16*)(F.lds + RING_OFF + SGW_OFF);
    LAS bf16* Ul = (LAS bf16*)(F.lds + RING_OFF + SGU_OFF);
    const float* b_s = in.p[30];
    const int lane = F.lane, r = lane & 31, h = lane >> 5, wr = F.wave >> 2, wc = F.wave & 3;
    constexpr int NU = (MP / GMC) * GMG;
    v4u vnr[4], wq[4], uq[4];
    if (F.vcu < NU) { const int n = F.vcu >> 4, g = F.vcu & 15;
#pragma unroll
        for (int i = 0; i < 4; ++i) { const int idx = F.tid + 512 * i, sidx = idx & 127, c8 = idx >> 7, trow = idx >> 4, c16 = idx & 15;
            vnr[i] = *(const GAS v4u*)(VN + (size_t)(n * GMC + sidx) * DM + g * 128 + 8 * c8);
            wq[i] = *(const GAS v4u*)(WS + ((size_t)g * GMC + trow) * GMC + 8 * c16);
            uq[i] = *(const GAS v4u*)(U + (size_t)(n * GMC + trow) * DM + g * 128 + 8 * c16); } }
    for (int u = F.vcu; u < NU; u += F.G) { const int n = u >> 4, g = u & 15;
        float bias[2];
#pragma unroll
        for (int ti = 0; ti < 2; ++ti) bias[ti] = b_s[g * GMC + 64 * wr + 32 * ti + r];
        __syncthreads();
#pragma unroll
        for (int i = 0; i < 4; ++i) { const int idx = F.tid + 512 * i, sidx = idx & 127, c8 = idx >> 7, trow = idx >> 4, c16 = idx & 15;
            const unsigned ww[4] = {vnr[i].x, vnr[i].y, vnr[i].z, vnr[i].w};
#pragma unroll
            for (int e = 0; e < 4; ++e) { VnT[(8 * c8 + 2 * e) * VNT_STRIDE + sidx] = (bf16)(ww[e] & 0xffffu); VnT[(8 * c8 + 2 * e + 1) * VNT_STRIDE + sidx] = (bf16)(ww[e] >> 16); }
            *(LAS v4u*)(Wl + trow * VNT_STRIDE + 8 * c16) = wq[i];
            *(LAS v4u*)(Ul + trow * VNT_STRIDE + 8 * c16) = uq[i]; }
        { const int un = u + F.G; if (un < NU) { const int nn = un >> 4, gn = un & 15;
#pragma unroll
            for (int i = 0; i < 4; ++i) { const int idx = F.tid + 512 * i, sidx = idx & 127, c8 = idx >> 7, trow = idx >> 4, c16 = idx & 15;
                vnr[i] = *(const GAS v4u*)(VN + (size_t)(nn * GMC + sidx) * DM + gn * 128 + 8 * c8);
                wq[i] = *(const GAS v4u*)(WS + ((size_t)gn * GMC + trow) * GMC + 8 * c16);
                uq[i] = *(const GAS v4u*)(U + (size_t)(nn * GMC + trow) * DM + gn * 128 + 8 * c16); } } }
        __syncthreads();
#pragma unroll
        for (int ti = 0; ti < 2; ++ti) { const int t = 64 * wr + 32 * ti + r;
            f32x16 acc;
#pragma unroll
            for (int e = 0; e < 16; ++e) acc[e] = 0.f;
#pragma unroll
            for (int ks = 0; ks < 8; ++ks) { const bf16x8 af = *(const LAS bf16x8*)(VnT + (32 * wc + r) * VNT_STRIDE + 16 * ks + 8 * h);
                const bf16x8 bfv = *(const LAS bf16x8*)(Wl + t * VNT_STRIDE + 16 * ks + 8 * h);
                acc = __builtin_amdgcn_mfma_f32_32x32x16_bf16(af, bfv, acc, 0, 0, 0); }
#pragma unroll
            for (int gq = 0; gq < 4; ++gq) { LAS v2u* up = (LAS v2u*)(Ul + t * VNT_STRIDE + 32 * wc + 8 * gq + 4 * h); const v2u uw = *up;
                const float u0 = bf2f((bf16)(uw.x & 0xffffu)), u1 = bf2f((bf16)(uw.x >> 16)), u2 = bf2f((bf16)(uw.y & 0xffffu)), u3 = bf2f((bf16)(uw.y >> 16));
                v2u w; w.x = cvt_pk_bf16(u0 * (acc[4 * gq] + bias[ti]), u1 * (acc[4 * gq + 1] + bias[ti])); w.y = cvt_pk_bf16(u2 * (acc[4 * gq + 2] + bias[ti]), u3 * (acc[4 * gq + 3] + bias[ti]));
                *up = w; } }
        __syncthreads();
#pragma unroll
        for (int i = 0; i < 4; ++i) { const int idx = F.tid + 512 * i, trow = idx >> 4, c16 = idx & 15;
            const v4u w = *(const LAS v4u*)(Ul + trow * VNT_STRIDE + 8 * c16);
            *(GAS v4u*)(A3 + (size_t)(n * GMC + trow) * DM + g * 128 + 8 * c16) = w; }
    }
    __syncthreads();
}

#ifndef MK_PER_PHASE
#define MK_PER_PHASE 0
#endif
#ifndef REP_P0
#define REP_P0 1
#endif
#ifndef REP_SK
#define REP_SK 1
#endif
#ifndef REP_NORM
#define REP_NORM 1
#endif
#ifndef REP_MISC
#define REP_MISC 1
#endif
#ifndef REP_ATT
#define REP_ATT 1
#endif
#ifndef REP_CONV
#define REP_CONV 1
#endif
#ifndef REP_S5
#define REP_S5 1
#endif
#ifndef REP_GML
#define REP_GML 1
#endif
#ifndef REP_SGU
#define REP_SGU 1
#endif
#ifndef REP_BAR
#define REP_BAR 1
#endif
#ifndef REP_G1
#define REP_G1 1
#endif
#ifndef REP_G2
#define REP_G2 1
#endif
#ifndef REP_DN
#define REP_DN 1
#endif
#ifndef REP_G3
#define REP_G3 1
#endif
#ifndef REP_EPI
#define REP_EPI 1
#endif
#ifndef DN_IN_TAIL
#define DN_IN_TAIL 1
#endif
struct Args { In in; float* out; unsigned char* ws; int ph_lo, ph_hi; };

struct ColPlain { __device__ __forceinline__ int operator()(int cg, int) const { return 32 * cg; } };
struct ColCin { __device__ __forceinline__ int operator()(int cg, int b) const { return b * DM + 32 * cg; } };
struct RowPlain { __device__ __forceinline__ int operator()(int u, int) const { return 32 * u; } };
struct RowPair { __device__ __forceinline__ int operator()(int u, int b) const { return 256 * (u >> 2) + 128 * b + 32 * (u & 3); } };
struct RowCin { __device__ __forceinline__ int operator()(int u, int b) const { return b == 2 ? 2 * DM + 32 * u : 256 * (u >> 2) + 128 * b + 32 * (u & 3); } };


__global__ void __launch_bounds__(NWAVES * 64, 2) hybrid_fwd(Args args) {
    extern __shared__ __attribute__((aligned(16))) unsigned char lds[];
    Frame F;
    F.lds = (LAS unsigned char*)lds;
    F.MISC = (volatile LAS unsigned*)(F.lds + MISC_OFF);
    F.tid = threadIdx.x; F.lane = F.tid & 63; F.wave = __builtin_amdgcn_readfirstlane(F.tid >> 6);
    F.G = gridDim.x; { const int bx = blockIdx.x; F.vcu = (F.G % 8 == 0) ? (bx % 8) * (F.G / 8) + bx / 8 : bx; }
    F.ws = args.ws; F.out = args.out;
    const In& in = args.in;
    unsigned char* ws = args.ws;
    gu32* ctl = (gu32*)(ws + WS_CTL);
    for (int u = F.tid; u < (LDS_BYTES - LDSCTL_OFF) / 4; u += NWAVES * 64) ((LAS unsigned*)(F.lds + LDSCTL_OFF))[u] = 0u;
    __syncthreads();
    XcdBarrier bar; bar.bar = (unsigned*)(ctl + CW_BAR); bar.x = 0; bar.st = nullptr;
    if (!MK_PER_PHASE) bar = xcd_barrier_post((unsigned*)(ctl + CW_BAR), F.MISC + 8);
#define GRID_BAR() do { if (!MK_PER_PHASE) { for (int rb_ = 0; rb_ < REP_BAR; ++rb_) xcd_barrier(bar); } } while (0)
    const int lo = args.ph_lo, hi = args.ph_hi;
    int phase_no = 0;
#define PHASE_BEGIN if (lo <= phase_no && phase_no < hi) {
#define PHASE_END   GRID_BAR(); } ++phase_no;

    bf16* const Hb = (bf16*)(ws + WS_H); bf16* const T0 = (bf16*)(ws + WS_T0); bf16* const T1 = (bf16*)(ws + WS_T1); bf16* const T2 = (bf16*)(ws + WS_T2);
    bf16* const KB = (bf16*)(ws + WS_KB); bf16* const VB = (bf16*)(ws + WS_VB); bf16* const ACT = (bf16*)(ws + WS_ACT); bf16* const Dm = (bf16*)(ws + WS_D); float* const PSB = (float*)(ws + WS_P); unsigned* const HQ = (unsigned*)(ws + WS_HQ); float* const RS = (float*)(ws + WS_RS);
    float* const Y_OUT = args.out + O_Y; bf16* const XB = (bf16*)(ws + WS_X);
    const float* const norm_g = in.p[7];
#define NG(l, k) (norm_g + ((size_t)(l) * 6 + (k)) * DM)

    PHASE_BEGIN
        for (int rp_ = 0; rp_ < REP_P0; ++rp_) { p0_convert(F, in); if (!DN_IN_TAIL) { for (int j = 0; j < 8; ++j) cvt_job(F, in, CJ_DN + j, F.vcu * NWAVES + F.wave, F.G * NWAVES); } }
        resid_norm_fast<false, false>(F, XB, nullptr, (const bf16*)in.p[0], 0.f, nullptr, NG(0, 0), Hb, HQ, RS);
        resid_norm_rows<false, true, false>(F, in.p[0], in.p[1], XB, nullptr, nullptr, 0.f, nullptr, NG(0, 0), Hb, HQ, RS, nullptr, 0, nullptr, nullptr, MP);
    PHASE_END

#define FFN_PHASES(L, S, G_POST, G_NEXT, NEXT_Q8, LASTP) \
    PHASE_BEGIN { \
        const signed char* Wgu = (const signed char*)(ws + WS_WGU + (size_t)((L) * 2 + (S)) * SZ_WGU); const float* CSc = (const float*)(ws + WS_CS) + (size_t)((L) * 2 + (S)) * NGU; \
        pg8::Gemm g{(const bf16*)HQ, (const bf16*)Wgu, MP, NGU, DM / 2}; pg8::StaticOrder S_; S_.init(MP, NGU, F.G, (int)blockIdx.x); \
        { pg8::Unit u_;        \
          _Pragma("unroll") for (int ui_ = 0; ui_ < 6; ++ui_) if (S_.next(ui_, u_)) { const float* src_ = (F.wave < 4) ? RS + u_.pm * 256 + 64 * F.wave + F.lane : CSc + u_.pn * 256 + 64 * (F.wave - 4) + F.lane; \
              __builtin_amdgcn_global_load_lds((const unsigned*)src_, (LAS unsigned*)(F.lds + SC_OFF + (ui_ * 512 + 64 * F.wave) * 4), 4, 0, 0); } } \
        pg8::EpiPairI8 E{ACT, DFF, (const LAS float*)(F.lds + SC_OFF)}; \
        pg8::gemm_phase<pg8::EpiPairI8, pg8::StaticOrder, true, true, true>(F.lds + RING_OFF, g, S_, E); if (REP_G1 > 1) pg8::gemm_phase<pg8::EpiPairI8, pg8::StaticOrder, true, true, true>(F.lds + RING_OFF, g, S_, E); \
        { struct EpiS { bf16* act; __device__ __forceinline__ void operator()(int u, int row, int col, const float (&v)[2]) const { act[(size_t)(MP + row) * DFF + 32 * u + col] = f2bf(silu_f(v[0]) * v[1]); } }; \
          const int cut_ = ((MP / 256) * (NGU / 256)) % F.G, nt_ = F.G - cut_;        \
          for (int rs_ = 0; rs_ < REP_SK; ++rs_) skinny_gemm_i8(F, (const signed char*)HQ + (size_t)MP * DM, RS + MP, Wgu, CSc, DFF / 32, (int)blockIdx.x >= cut_ ? (int)blockIdx.x - cut_ : DFF, nt_, EpiS{ACT}); \
          if (DN_IN_TAIL) for (int rc_ = 0; rc_ < REP_DN; ++rc_) { if ((int)blockIdx.x >= cut_) cvt_job(F, in, CJ_DN + (L) * 2 + (S), ((int)blockIdx.x - cut_) * NWAVES + F.wave, nt_ * NWAVES);     \
          else if (cut_ == 0) cvt_job(F, in, CJ_DN + (L) * 2 + (S), (int)blockIdx.x * NWAVES + F.wave, F.G * NWAVES); } } \
    } PHASE_END \
    PHASE_BEGIN { \
        const bf16* Wdn = (const bf16*)(ws + WS_WDN + (size_t)((L) * 2 + (S)) * SZ_WDN); \
        for (int rs_ = 0; rs_ < REP_SK; ++rs_) skinny_ks<1>(F, ACT + (size_t)MP * DFF, DFF, Wdn, DFF, DM / 32, 4, RowPlain{}, ColPlain{}, PSB, DM); \
        pg8::Gemm g{ACT, Wdn, MP, DM, DFF}; pg8::StaticOrder S_; S_.init(MP, DM, F.G, (int)blockIdx.x); \
        pg8::EpiSplit<0> E{Dm, DM, 1 << 20, nullptr, 0, 0, nullptr, 0}; \
        pg8::gemm_phase<pg8::EpiSplit<0>, pg8::StaticOrder, true, true>(F.lds + RING_OFF, g, S_, E); if (REP_G2 > 1) pg8::gemm_phase<pg8::EpiSplit<0>, pg8::StaticOrder, true, true>(F.lds + RING_OFF, g, S_, E); \
    } PHASE_END \
    PHASE_BEGIN \
        resid_norm_fast<(LASTP) != 0>(F, XB, Y_OUT, Dm, 0.5f, G_POST, G_NEXT, Hb, (NEXT_Q8) ? HQ : nullptr, RS); \
        resid_norm_sample_wg<(LASTP) != 0>(F, XB, Y_OUT, 0.5f, G_POST, G_NEXT, Hb, (NEXT_Q8) ? HQ : nullptr, RS, PSB, nullptr, nullptr); \
        for (int rn_ = 1; rn_ < REP_NORM; ++rn_) resid_norm_fast<(LASTP) != 0>(F, XB, Y_OUT, Dm, (LASTP) ? 0.5f : 0.0f, G_POST, G_NEXT, Hb, (NEXT_Q8) ? HQ : nullptr, RS); \
    PHASE_END

#define OUTPROJ_PHASES(L, A_BUF, W_OFF) \
    PHASE_BEGIN { \
        const bf16* W = (const bf16*)(ws + (W_OFF)); \
        for (int rs_ = 0; rs_ < REP_SK; ++rs_) skinny_ks<1>(F, (A_BUF) + (size_t)MP * DM, DM, W, DM, DM / 32, 4, RowPlain{}, ColPlain{}, PSB, DM); \
        pg8::Gemm g{(A_BUF), W, MP, DM, DM}; pg8::StaticOrder S_; S_.init(MP, DM, F.G, (int)blockIdx.x); \
        pg8::EpiSplit<0> E{Dm, DM, 1 << 20, nullptr, 0, 0, nullptr, 0}; \
        pg8::gemm_phase<pg8::EpiSplit<0>, pg8::StaticOrder, true, true>(F.lds + RING_OFF, g, S_, E); if (REP_G3 > 1) pg8::gemm_phase<pg8::EpiSplit<0>, pg8::StaticOrder, true, true>(F.lds + RING_OFF, g, S_, E); \
    } PHASE_END \
    PHASE_BEGIN \
        resid_norm_fast<false>(F, XB, nullptr, Dm, 1.0f, NG(L, 3), NG(L, 4), Hb, HQ, RS); \
        resid_norm_sample_wg<false>(F, XB, nullptr, 1.0f, NG(L, 3), NG(L, 4), Hb, HQ, RS, PSB, nullptr, nullptr); \
        for (int rn_ = 1; rn_ < REP_NORM; ++rn_) resid_norm_fast<false>(F, XB, nullptr, Dm, 0.0f, NG(L, 3), NG(L, 4), Hb, HQ, RS); \
    PHASE_END

    FFN_PHASES(0, 0, NG(0, 1), NG(0, 2), 0, 0)
    PHASE_BEGIN {
        const bf16* W = (const bf16*)(ws + WS_WQKV);
        pg8::Gemm g{Hb, W, MP, NQKV, DM}; pg8::StaticOrder S_; S_.init(MP, NQKV, F.G, (int)blockIdx.x);
        pg8::EpiSplit<0> E{T0, DM, 8, KB, 256, 1, VB, 256};
        pg8::gemm_phase<pg8::EpiSplit<0>, pg8::StaticOrder, true, true>(F.lds + RING_OFF, g, S_, E); if (REP_G3 > 1) pg8::gemm_phase<pg8::EpiSplit<0>, pg8::StaticOrder, true, true>(F.lds + RING_OFF, g, S_, E);
        { struct EpiS { bf16 *q, *k, *v; __device__ __forceinline__ void operator()(int u, int row, int col, const float (&x)[1]) const { const int c = 32 * u + col; const size_t r = (size_t)(MP + row);
              if (c < DM) q[r * DM + c] = f2bf(x[0]); else if (c < DM + 256) k[r * 256 + c - DM] = f2bf(x[0]); else v[r * 256 + c - DM - 256] = f2bf(x[0]); } };
          const int cut_ = ((MP / 256) * (NQKV / 256)) % F.G, nt_ = F.G - cut_;
          for (int rs_ = 0; rs_ < REP_SK; ++rs_) skinny_gemm<1>(F, Hb + (size_t)MP * DM, DM, W, DM, NQKV / 32, (int)blockIdx.x >= cut_ ? (int)blockIdx.x - cut_ : NQKV, nt_, RowPlain{}, EpiS{T0, KB, VB});
          if ((int)blockIdx.x >= cut_ || cut_ == 0) { const int wi_ = (cut_ == 0 ? (int)blockIdx.x : (int)blockIdx.x - cut_) * NWAVES + F.wave, nw_ = (cut_ == 0 ? F.G : nt_) * NWAVES;
              cvt_job(F, in, CJ_O, wi_, nw_); cvt_job(F, in, CJ_CIN, wi_, nw_); cvt_job(F, in, CJ_COUT, wi_, nw_); } }
    } PHASE_END
    PHASE_BEGIN
        for (int rm_ = 0; rm_ < REP_MISC * REP_ATT; ++rm_) { attn_phase_all(F, in, T0, KB, VB, T1); }
    PHASE_END
    OUTPROJ_PHASES(0, T1, WS_WO)
    FFN_PHASES(0, 1, NG(0, 5), NG(1, 0), 1, 0)

    FFN_PHASES(1, 0, NG(1, 1), NG(1, 2), 0, 0)
    PHASE_BEGIN {
        const bf16* W = (const bf16*)(ws + WS_WCIN);
        for (int rs_ = 0; rs_ < REP_SK; ++rs_) skinny_ks<3>(F, Hb + (size_t)MP * DM, DM, W, DM, DM / 32, 4, RowCin{}, ColCin{}, PSB, 3 * DM);
        pg8::Gemm g{Hb, W, MP, 3 * DM, DM}; pg8::StaticOrder S_; S_.init(MP, 3 * DM, F.G, (int)blockIdx.x);
        pg8::EpiPair<1> E{T0, DM, 16, T1, DM};
        pg8::gemm_phase<pg8::EpiPair<1>, pg8::StaticOrder, true, true>(F.lds + RING_OFF, g, S_, E); if (REP_G3 > 1) pg8::gemm_phase<pg8::EpiPair<1>, pg8::StaticOrder, true, true>(F.lds + RING_OFF, g, S_, E);
    } PHASE_END
    PHASE_BEGIN
        for (int rm_ = 0; rm_ < REP_MISC * REP_CONV; ++rm_) { conv_pass(F, in, T0, T1, T2, PSB, 4); }
    PHASE_END
    OUTPROJ_PHASES(1, T2, WS_WCOUT)
    FFN_PHASES(1, 1, NG(1, 5), NG(2, 0), 1, 0)

    FFN_PHASES(2, 0, NG(2, 1), NG(2, 2), 0, 0)
    PHASE_BEGIN
        s5_phase<0>(F, in, Hb, T0); for (int rm_ = 1; rm_ < REP_MISC * REP_S5; ++rm_) { s5_phase<S5_XMODE>(F, in, Hb, T0); }
    PHASE_END
    PHASE_BEGIN {
        const bf16* W = (const bf16*)(ws + WS_WGATE);
        for (int rs_ = 0; rs_ < REP_SK; ++rs_) skinny_ks<1>(F, T0 + (size_t)MP * DM, DM, W, DM, DM / 32, 4, RowPlain{}, ColPlain{}, PSB, DM);
        pg8::Gemm g{T0, W, MP, DM, DM}; pg8::StaticOrder S_; S_.init(MP, DM, F.G, (int)blockIdx.x);
        pg8::EpiGate E{Dm, T0, in.p[25], DM};
        pg8::gemm_phase<pg8::EpiGate, pg8::StaticOrder, true, true>(F.lds + RING_OFF, g, S_, E); if (REP_G3 > 1) pg8::gemm_phase<pg8::EpiGate, pg8::StaticOrder, true, true>(F.lds + RING_OFF, g, S_, E);
    } PHASE_END
    PHASE_BEGIN
        resid_norm_fast<false>(F, XB, nullptr, Dm, 1.0f, NG(2, 3), NG(2, 4), Hb, HQ, RS);
        resid_norm_sample_wg<false>(F, XB, nullptr, 1.0f, NG(2, 3), NG(2, 4), Hb, HQ, RS, PSB, T0, in.p[25]);
        for (int rn_ = 1; rn_ < REP_NORM; ++rn_) resid_norm_fast<false>(F, XB, nullptr, Dm, 0.0f, NG(2, 3), NG(2, 4), Hb, HQ, RS);
    PHASE_END
    FFN_PHASES(2, 1, NG(2, 5), NG(3, 0), 1, 0)

    FFN_PHASES(3, 0, NG(3, 1), NG(3, 2), 0, 0)
    PHASE_BEGIN {
        const bf16* W = (const bf16*)(ws + WS_WUV);
        for (int rs_ = 0; rs_ < REP_SK; ++rs_) skinny_ks<1>(F, Hb + (size_t)MP * DM, DM, W, DM, 2 * DM / 32, 2, RowPlain{}, ColPlain{}, PSB, 2 * DM);
        pg8::Gemm g{Hb, W, MP, 2 * DM, DM}; pg8::StaticOrder S_; S_.init(MP, 2 * DM, F.G, (int)blockIdx.x);
        pg8::EpiSplit<1> E{T0, DM, 8, T1, DM, 8, nullptr, 0};
        pg8::gemm_phase<pg8::EpiSplit<1>, pg8::StaticOrder, true, true>(F.lds + RING_OFF, g, S_, E); if (REP_G3 > 1) pg8::gemm_phase<pg8::EpiSplit<1>, pg8::StaticOrder, true, true>(F.lds + RING_OFF, g, S_, E);
    } PHASE_END
    PHASE_BEGIN
        for (int rm_ = 0; rm_ < REP_MISC * REP_GML; ++rm_) { gm_ln_pass(F, in, T0, T1, T2, Hb, PSB, 2); }
    PHASE_END
    PHASE_BEGIN
        for (int rm_ = 0; rm_ < REP_MISC * REP_SGU; ++rm_) { sgu_phase(F, in, T0, T2, (const bf16*)(ws + WS_WS), Hb); }
    PHASE_END
    OUTPROJ_PHASES(3, Hb, WS_WGOUT)
    FFN_PHASES(3, 1, NG(3, 5), nullptr, 0, 1)
#undef NG
}
constexpr int N_PHASES = 1 + 8 * 3 + (2 + 2) + (2 + 2) + (2 + 1) + (3 + 2);

extern "C" void kernel_launch(void* const* d_in, const int* in_sizes, int n_in, void* d_out, int out_size, void* d_ws, size_t ws_size, hipStream_t stream) {
    static int grid = 0;
    if (grid == 0) {
        if (n_in != 32 || (size_t)out_size != O_END || ws_size < WS_END) { fprintf(stderr, "kernel_launch: unexpected sizes: n_in %d out %d (want %zu) ws %zu (want >= %zu); nothing launched\n", n_in, out_size, (size_t)O_END, ws_size, (size_t)WS_END); grid = -1; return; }
        int dev = 0, cus = 0, per_cu = 0;
        if (hipGetDevice(&dev) != hipSuccess || hipDeviceGetAttribute(&cus, hipDeviceAttributeMultiprocessorCount, dev) != hipSuccess) { grid = -1; return; }
        if (hipFuncSetAttribute((const void*)hybrid_fwd, hipFuncAttributeMaxDynamicSharedMemorySize, LDS_BYTES) != hipSuccess) { fprintf(stderr, "kernel_launch: hipFuncSetAttribute failed\n"); grid = -1; return; }
        if (hipOccupancyMaxActiveBlocksPerMultiprocessor(&per_cu, (const void*)hybrid_fwd, NWAVES * 64, LDS_BYTES) != hipSuccess || per_cu < 1) { fprintf(stderr, "kernel_launch: occupancy query says %d blocks per CU\n", per_cu); }
        (void)hipGetLastError();
        grid = cus;
    }
    if (grid < 0) return;
    (void)hipMemsetAsync((char*)d_ws + WS_CTL, 0, CTL_ZERO_BYTES, stream);
    Args a{};
    for (int i = 0; i < 32; ++i) a.in.p[i] = (const float*)d_in[i];
    a.out = (float*)d_out; a.ws = (unsigned char*)d_ws;
#if MK_PER_PHASE
    for (int p = 0; p < N_PHASES; ++p) { a.ph_lo = p; a.ph_hi = p + 1; hipLaunchKernelGGL(hybrid_fwd, dim3(grid), dim3(NWAVES * 64), LDS_BYTES, stream, a); }
#else
    a.ph_lo = 0; a.ph_hi = N_PHASES;
    hipLaunchKernelGGL(hybrid_fwd, dim3(grid), dim3(NWAVES * 64), LDS_BYTES, stream, a);
#endif
}
```
